# Optimizing an MI355X kernel written in HIP

```python
import jax, jax.numpy as jnp
from jax import lax
import numpy as np

D_MODEL = 1024
BATCH = 4
SEQ = 8192
DEPTH = 1

GRID_W = 64
CTX_LEN = 256
HEAD_DIM = 64
N_Q_HEADS = 8
N_KV_HEADS = 2
Q_PER_KV = N_Q_HEADS // N_KV_HEADS
ATTN_WIDTH = N_Q_HEADS * HEAD_DIM
GM_GROUPS = 8
GM_GROUP_DIM = 64
GM_WIDTH = GM_GROUPS * GM_GROUP_DIM
CHUNK = 128
Q_BLOCK = 128
D_FF = 4 * D_MODEL
ROPE_THETA = 10000.0
ROT_AXIS_DIM = HEAD_DIM // 2
EPS = 1e-6
N_MOD = 6

K_W = N_KV_HEADS * HEAD_DIM
V_W = N_KV_HEADS * HEAD_DIM
KV_COLS = K_W + V_W
Q_W = ATTN_WIDTH
U_W = GM_WIDTH
VG_W = GM_WIDTH
GA_W = D_MODEL
GB_W = D_MODEL
D_IN = KV_COLS + Q_W + U_W + VG_W + GA_W + GB_W
REST_SPLITS = tuple(int(s) for s in np.cumsum([Q_W, U_W, VG_W, GA_W]))

kernel_name = "hybrid_gqa_gmlp_dit_block"


def rmsnorm(x, g):
    xf = x.astype(jnp.float32)
    y = xf * lax.rsqrt(jnp.mean(xf * xf, axis=-1, keepdims=True) + EPS)
    return (y * g.astype(jnp.float32)).astype(x.dtype)


def modulate(x, g, shift, scale):
    return rmsnorm(x, g) * (1 + scale) + shift


def axial_rope_tables(n_tokens, dtype):
    rows = n_tokens // GRID_W
    row = jnp.repeat(jnp.arange(rows, dtype=jnp.float32), GRID_W)
    col = jnp.tile(jnp.arange(GRID_W, dtype=jnp.float32), rows)
    inv = ROPE_THETA ** (-jnp.arange(0, ROT_AXIS_DIM, 2, dtype=jnp.float32) / ROT_AXIS_DIM)
    ang = jnp.concatenate([row[:, None] * inv, col[:, None] * inv], axis=-1)
    return jnp.cos(ang).astype(dtype), jnp.sin(ang).astype(dtype)


def apply_rope(x, cos, sin):
    x1, x2 = x[..., :HEAD_DIM // 2], x[..., HEAD_DIM // 2:]
    return jnp.concatenate([x1 * cos - x2 * sin, x2 * cos + x1 * sin], axis=-1)


def q_heads(p):
    b, n, _ = p.shape
    return p.reshape(b, n, N_KV_HEADS, Q_PER_KV, HEAD_DIM).transpose(0, 2, 3, 1, 4)


def kv_heads(p):
    b, n, _ = p.shape
    return p.reshape(b, n, N_KV_HEADS, HEAD_DIM).transpose(0, 2, 1, 3)


def merge_heads(o):
    b, kv, g, n, d = o.shape
    return o.transpose(0, 3, 1, 2, 4).reshape(b, n, kv * g * d)


def attend(q, k, v):
    s = jnp.einsum('bkgqd,bknd->bkgqn', q, k, preferred_element_type=jnp.float32)
    p = jax.nn.softmax(s, axis=-1).astype(v.dtype)
    return jnp.einsum('bkgqn,bknd->bkgqd', p, v)


def attend_blocked(q, k, v):
    b, kv, g, n, d = q.shape
    nb = n // Q_BLOCK
    qb = jnp.moveaxis(q.reshape(b, kv, g, nb, Q_BLOCK, d), 3, 0)
    ob = lax.map(lambda blk: attend(blk, k, v), qb)
    return jnp.moveaxis(ob, 0, 3).reshape(b, kv, g, n, d)


def gmlp_spatial(u, v, gm_norm_g, gm_ws, gm_bs):
    b, n, _ = u.shape
    nc = n // CHUNK
    vg = v.reshape(b, nc, CHUNK, GM_GROUPS, GM_GROUP_DIM)
    vg = rmsnorm(vg, gm_norm_g)
    s = jnp.einsum('gpq,bnqgc->bnpgc', gm_ws.astype(vg.dtype), vg) + gm_bs.T[:, :, None].astype(vg.dtype)
    return u * s.reshape(b, n, GM_WIDTH)


def branch_merge(attn_o, gm_o, ga_logit, gb_logit, w_br_attn, w_br_gm, w_out):
    y = jax.nn.sigmoid(ga_logit) * (attn_o @ w_br_attn) + jax.nn.sigmoid(gb_logit) * (gm_o @ w_br_gm)
    return y @ w_out


def sq_relu_mlp(h, w1, w2):
    return jnp.square(jax.nn.relu(h @ w1)) @ w2


def setup_inputs(seed: int = 0) -> dict:
    key = jax.random.key(seed)
    ks = jax.random.split(key, 20)
    f32 = jnp.float32
    nrm = lambda k, shape, s: jax.random.normal(k, shape, f32) * s
    return {
        "x": nrm(ks[0], (BATCH, SEQ, D_MODEL), 1.0),
        "c": nrm(ks[1], (BATCH, D_MODEL), 1.0),
        "ctx": nrm(ks[2], (BATCH, CTX_LEN, D_MODEL), 1.0),
        "c_ctx": nrm(ks[3], (D_MODEL,), 1.0),
        "w_mod": nrm(ks[4], (DEPTH, D_MODEL, N_MOD * D_MODEL), 0.02),
        "b_mod": nrm(ks[5], (DEPTH, N_MOD * D_MODEL), 0.02),
        "norm1_g": 1.0 + nrm(ks[6], (DEPTH, D_MODEL), 0.02),
        "norm2_g": 1.0 + nrm(ks[7], (DEPTH, D_MODEL), 0.02),
        "w_in": nrm(ks[8], (DEPTH, D_MODEL, D_IN), D_MODEL ** -0.5),
        "q_norm_g": 1.0 + nrm(ks[9], (DEPTH, HEAD_DIM), 0.02),
        "k_norm_g": 1.0 + nrm(ks[10], (DEPTH, HEAD_DIM), 0.02),
        "gm_norm_g": 1.0 + nrm(ks[11], (DEPTH, GM_GROUPS, GM_GROUP_DIM), 0.02),
        "gm_ws": nrm(ks[12], (DEPTH, GM_GROUPS, CHUNK, CHUNK), CHUNK ** -0.5),
        "gm_bs": 1.0 + nrm(ks[13], (DEPTH, GM_GROUPS, CHUNK), 0.02),
        "w_br_attn": nrm(ks[14], (DEPTH, ATTN_WIDTH, D_MODEL), ATTN_WIDTH ** -0.5),
        "w_br_gm": nrm(ks[15], (DEPTH, GM_WIDTH, D_MODEL), GM_WIDTH ** -0.5),
        "w_out": nrm(ks[16], (DEPTH, D_MODEL, D_MODEL), D_MODEL ** -0.5),
        "w_ff1": nrm(ks[17], (DEPTH, D_MODEL, D_FF), D_MODEL ** -0.5),
        "w_ff2": nrm(ks[18], (DEPTH, D_FF, D_MODEL), D_FF ** -0.5),
    }


def reference(x, c, ctx, c_ctx, w_mod, b_mod, norm1_g, norm2_g, w_in, q_norm_g, k_norm_g,
              gm_norm_g, gm_ws, gm_bs, w_br_attn, w_br_gm, w_out, w_ff1, w_ff2):
    n_tok = x.shape[1]
    cos, sin = axial_rope_tables(n_tok, x.dtype)
    q_scale = HEAD_DIM ** -0.5
    ctx_s = ctx
    for l in range(DEPTH):
        more_layers = l + 1 < DEPTH
        mod_x = jax.nn.silu(c) @ w_mod[l] + b_mod[l]
        sh1, sc1, g1, sh2, sc2, g2 = jnp.split(mod_x[:, None, :], N_MOD, axis=-1)
        mod_c = jax.nn.silu(c_ctx) @ w_mod[l] + b_mod[l]
        sh1c, sc1c, g1c, sh2c, sc2c, g2c = jnp.split(mod_c, N_MOD, axis=-1)

        h_c = modulate(ctx_s, norm1_g[l], sh1c, sc1c)
        n_cols = D_IN if more_layers else KV_COLS
        p_c = h_c @ w_in[l][:, :n_cols]
        k_c = rmsnorm(kv_heads(p_c[..., :K_W]), k_norm_g[l])
        v_c = kv_heads(p_c[..., K_W:KV_COLS])

        h_x = modulate(x, norm1_g[l], sh1, sc1)
        p_x = h_x @ w_in[l]
        k_x = apply_rope(rmsnorm(kv_heads(p_x[..., :K_W]), k_norm_g[l]), cos, sin)
        v_x = kv_heads(p_x[..., K_W:KV_COLS])
        q_x, u_x, vg_x, ga_x, gb_x = jnp.split(p_x[..., KV_COLS:], REST_SPLITS, axis=-1)
        q_x = apply_rope(rmsnorm(q_heads(q_x), q_norm_g[l]), cos, sin) * q_scale
        k_all = jnp.concatenate([k_c, k_x], axis=2)
        v_all = jnp.concatenate([v_c, v_x], axis=2)
        attn_x = merge_heads(attend_blocked(q_x, k_all, v_all))
        gm_x = gmlp_spatial(jax.nn.gelu(u_x), jax.nn.gelu(vg_x), gm_norm_g[l], gm_ws[l], gm_bs[l])
        x = x + g1 * branch_merge(attn_x, gm_x, ga_x, gb_x, w_br_attn[l], w_br_gm[l], w_out[l])

        h2 = modulate(x, norm2_g[l], sh2, sc2)
        x = x + g2 * sq_relu_mlp(h2, w_ff1[l], w_ff2[l])

        if more_layers:
            q_c, u_c, vg_c, ga_c, gb_c = jnp.split(p_c[..., KV_COLS:], REST_SPLITS, axis=-1)
            q_c = rmsnorm(q_heads(q_c), q_norm_g[l]) * q_scale
            attn_c = merge_heads(attend(q_c, k_c, v_c))
            gm_c = gmlp_spatial(jax.nn.gelu(u_c), jax.nn.gelu(vg_c), gm_norm_g[l], gm_ws[l], gm_bs[l])
            ctx_s = ctx_s + g1c * branch_merge(attn_c, gm_c, ga_c, gb_c, w_br_attn[l], w_br_gm[l], w_out[l])
            h2c = modulate(ctx_s, norm2_g[l], sh2c, sc2c)
            ctx_s = ctx_s + g2c * sq_relu_mlp(h2c, w_ff1[l], w_ff2[l])
    return x
```

```cpp
#include <hip/hip_runtime.h>
#include <cstdio>
#include <cstdint>

typedef unsigned short bf16_t;

constexpr int DM = 1024, BATCH = 4, SEQ = 8192, GRID_W = 64, CTX = 256, HD = 64, NQH = 8, NKVH = 2;
constexpr int MTOK = BATCH * SEQ;
constexpr int MCTX = BATCH * CTX;
constexpr int NKEY = CTX + SEQ;
constexpr int D_IN = 3840, D_FF = 4096, NMOD = 6 * DM;
constexpr int COL_K = 0, COL_V = 128, COL_Q = 256, COL_U = 768, COL_VG = 1280, COL_GA = 1792, COL_GB = 2816;
constexpr float EPS = 1e-6f;
constexpr float QSCALE_LOG2E = 0.125f * 1.4426950408889634f;

constexpr size_t MiB = 1u << 20;
constexpr size_t WS_CTL = 0;
constexpr size_t WS_MOD = 1 * MiB;
constexpr size_t WS_CVEC = WS_MOD + 128 * 1024;
constexpr size_t WS_ROPE = WS_CVEC + 64 * 1024;
constexpr size_t WS_WIN = 2 * MiB, WS_WM = 10 * MiB, WS_WOUT = 12 * MiB, WS_W1 = 14 * MiB, WS_W2 = 22 * MiB, WS_WS = 30 * MiB, WS_SSQ = 31 * MiB;
constexpr size_t WS_XN = 34 * MiB;
constexpr size_t WS_Y = WS_XN;
constexpr size_t WS_K = 100 * MiB, WS_V = 109 * MiB;
constexpr size_t WS_GA = 118 * MiB, WS_GB = 182 * MiB;
constexpr size_t WS_Q = 246 * MiB, WS_U = 278 * MiB, WS_VG = 310 * MiB;
constexpr size_t WS_XN8 = 342 * MiB, WS_WIN8 = 14 * MiB;
constexpr size_t WS_AG = 342 * MiB;
constexpr size_t WS_XN2 = 406 * MiB;
constexpr size_t WS_K8 = WS_XN2, WS_Q8 = WS_XN2 + 8 * MiB, WS_V8T = WS_XN2 + 26 * MiB;
constexpr size_t WS_HM = 34 * MiB;
constexpr size_t WS_W1S = 470 * MiB;
constexpr size_t WS_END = 502 * MiB;

__device__ __forceinline__ float bf2f(bf16_t v) { return __uint_as_float(((unsigned)v) << 16); }
__device__ __forceinline__ bf16_t f2bf(float f) { unsigned u = __float_as_uint(f); return (bf16_t)((u + 0x7fffu + ((u >> 16) & 1u)) >> 16); }
__device__ __forceinline__ float siluf_(float x) { return x / (1.0f + __expf(-x)); }
__device__ __forceinline__ float wave_sum(float v) {
#pragma unroll
    for (int o = 1; o < 64; o <<= 1) v += __shfl_xor(v, o);
    return v;
}


namespace pg8 {
#define PG8_LAS __attribute__((address_space(3)))
typedef short bf16x8 __attribute__((ext_vector_type(8)));
typedef float f32x4 __attribute__((ext_vector_type(4)));
typedef unsigned u32x4 __attribute__((ext_vector_type(4)));
typedef unsigned u32x2 __attribute__((ext_vector_type(2)));
typedef int v4i_t __attribute__((ext_vector_type(4)));
constexpr int BM = 256, BK = 64, HALF = 128, HTB = HALF * BK * 2  , STAGE_BYTES = 8 * HTB, NXCD = 8, WGM = 8;

__host__ __device__ __forceinline__ int lds_byte(int r, int c) { const int st = (r >> 4) * 2 + (c >> 5), rr = r & 15, cc = c & 31, ob = rr * 64 + cc * 2; return st * 1024 + (ob ^ (((ob >> 9) & 1) << 5)); }
__host__ __device__ __forceinline__ void stage_rc(int b, int& R, int& C) { const int st = b / 1024, sb = b % 1024, swz = sb ^ (((sb >> 9) & 1) << 5); R = (st >> 1) * 16 + swz / 64; C = (st & 1) * 32 + (swz % 64) / 2; }
__host__ __device__ __forceinline__ int perm32(int rho) { const int n = rho >> 4, i = rho & 15; return 8 * (i >> 2) + 4 * n + (i & 3); }

struct Unit { int pm, pn, ko, keep; long bofs; };
struct Gemm { const bf16_t* A; const bf16_t* Bt; int lda, ldb, K; };

struct TileOrder {
    int nM, nN, nwg;
    __device__ __forceinline__ void init(int nM_, int nN_) { nM = nM_; nN = nN_; nwg = nM * nN; }
    __device__ __forceinline__ void tile(int L, int& pm, int& pn) const {
        int wgid = L; { const int q = nwg / NXCD, r = nwg % NXCD, xcd = wgid % NXCD, off = wgid / NXCD; wgid = (xcd < r ? xcd * (q + 1) : r * (q + 1) + (xcd - r) * q) + off; }
        const int nig = WGM * nN, gid = wgid / nig, fm = gid * WGM, gsz = (nM - fm) < WGM ? (nM - fm) : WGM;
        pm = fm + ((wgid % nig) % gsz); pn = (wgid % nig) / gsz;
    }
};
struct OrderPlain {
    TileOrder T; int G, c, rev;
    __device__ __forceinline__ void init(int nM, int nN, int G_, int c_, int rev_ = 0) { T.init(nM, nN); G = G_; c = c_; rev = rev_; }
    __device__ __forceinline__ bool next(int i, Unit& u) const { const int nr = T.nwg / G; if (i >= nr) return false; const int L = (rev ? nr - 1 - i : i) * G + c; if (L >= T.nwg) return false; T.tile(L, u.pm, u.pn); u.ko = 0; u.keep = 0; u.bofs = 0; return true; }
};
struct OrderBatchB {
    TileOrder T; int G, c; long bstride;
    __device__ __forceinline__ void init(int nM, int nN, int G_, int c_, long bs) { T.init(nM, nN); G = G_; c = c_; bstride = bs; }
    __device__ __forceinline__ bool next(int i, Unit& u) const { const int L = i * G + c; if (L >= T.nwg) return false; T.tile(L, u.pm, u.pn); u.ko = 0; u.keep = 0; u.bofs = (long)(u.pm >> 5) * bstride; return true; }
};
struct OrderInProj {
    TileOrder T; int G, c;
    __device__ __forceinline__ void init(int G_, int c_) { T.init(128, 15); G = G_; c = c_; }
    __device__ __forceinline__ bool next(int i, Unit& u) const { const int L = i * G + c; u.ko = 0; u.keep = 0; u.bofs = 0;
        if (L < T.nwg) { T.tile(L, u.pm, u.pn); return true; } if (L < T.nwg + 4) { u.pm = 128 + (L - T.nwg); u.pn = 0; return true; } return false; }
};
#ifndef IN_F8_TILES
#define IN_F8_TILES 11
#endif
struct OrderInProjF8 {
    TileOrder T; int G, c;
    __device__ __forceinline__ void init(int G_, int c_) { T.init(128, IN_F8_TILES); G = G_; c = c_; }
    __device__ __forceinline__ bool next(int i, Unit& u) const { const int L = i * G + c; u.ko = 0; u.keep = 0; u.bofs = 0;
        if (L < T.nwg) { int j; T.tile(L, u.pm, j); u.pn = j < 3 ? j : j + 4; return true; } if (L < T.nwg + 4) { u.pm = 128 + (L - T.nwg); u.pn = 0; return true; } return false; }
};
struct OrderInProjBf {
    TileOrder T; int G, c;
    __device__ __forceinline__ void init(int G_, int c_) { T.init(128, 15 - IN_F8_TILES); G = G_; c = c_; }
    __device__ __forceinline__ bool next(int i, Unit& u) const { const int L = i * G + c; u.ko = 0; u.keep = 0; u.bofs = 0; if (L >= T.nwg) return false; int j; T.tile(L, u.pm, j); u.pn = 3 + j; return true; }
};
struct OrderMerge {
    TileOrder T; int G, c;
    __device__ __forceinline__ void init(int nM, int nN, int G_, int c_) { T.init(nM, nN); G = G_; c = c_; }
    __device__ __forceinline__ bool next(int i, Unit& u) const { const int L = (i >> 1) * G + c; if (L >= T.nwg) return false; T.tile(L, u.pm, u.pn); u.ko = (i & 1) * 512; u.keep = (i & 1) ^ 1; u.bofs = 0; return true; }
};

__device__ __forceinline__ unsigned cvt_pk_bf16(float lo, float hi) { unsigned r; asm volatile("v_cvt_pk_bf16_f32 %0, %1, %2" : "=v"(r) : "v"(lo), "v"(hi)); return r; }
__device__ __forceinline__ float bf_lo(unsigned w) { return __uint_as_float(w << 16); }
__device__ __forceinline__ float bf_hi(unsigned w) { return __uint_as_float(w & 0xffff0000u); }
__device__ __forceinline__ float fast_rcp(float x) { return __builtin_amdgcn_rcpf(x); }
__device__ __forceinline__ float gelu_fast(float x) { const float u = x * (0.7978845608028654f + 0.0356774081363001f * x * x); return x * fast_rcp(1.0f + __builtin_amdgcn_exp2f(-2.885390081777927f * u)); }
__device__ __forceinline__ float sigmoid_fast(float x) { return fast_rcp(1.0f + __builtin_amdgcn_exp2f(-1.4426950408889634f * x)); }


struct EpiInProj {
    static constexpr bool PERM = true, AFTER_DRAIN = false; static constexpr int NST = 16;
    bf16_t *Kb, *Vb, *Qb, *Ub, *VGb, *GAb, *GBb; const float *qg, *kg, *gmg, *rope; unsigned char *K8, *Q8, *V8T; int skip16;
    __device__ __forceinline__ void operator()(f32x4 (&acc)[2][2][4][2], const Unit& u, int wr, int wc, int fr, int fq) const {
        const bool ctx = u.pm >= 128;
        const int hh = 4 * u.pn + wc;
        const int dl = 8 * fq;
        f32x4 gv[2][2];
        const bool is_k = hh < 2, is_q = (hh >= 4 && hh < 12), is_vg = (hh >= 20 && hh < 28);
        if (is_k || is_q || is_vg) { const float* g = is_k ? kg : (is_q ? qg : gmg + (hh - 20) * 64);
#pragma unroll
            for (int bj = 0; bj < 2; ++bj)
#pragma unroll
                for (int n = 0; n < 2; ++n) gv[bj][n] = *(const f32x4*)(g + 32 * bj + dl + 4 * n); }
        else {
#pragma unroll
            for (int bj = 0; bj < 2; ++bj)
#pragma unroll
                for (int n = 0; n < 2; ++n) gv[bj][n] = (f32x4){1.f, 1.f, 1.f, 1.f}; }
        bf16_t* dbase; int pitch;
        if (hh < 2) { dbase = Kb + hh * 64; pitch = 128; } else if (hh < 4) { dbase = Vb + (hh - 2) * 64; pitch = 128; }
        else if (hh < 12) { dbase = Qb + (hh - 4) * 64; pitch = 512; } else if (hh < 20) { dbase = Ub + (hh - 12) * 64; pitch = 512; }
        else if (hh < 28) { dbase = VGb + (hh - 20) * 64; pitch = 512; } else { dbase = GAb + (u.pn - 7) * 128 + wc * 32; pitch = 1024; }
        const bool kv = hh < 4;
        const size_t rowbase = ctx ? (size_t)(u.pm - 128) * NKEY : (kv ? (size_t)(u.pm >> 5) * NKEY + CTX + (size_t)(u.pm & 31) * 256 : (size_t)u.pm * 256);
#pragma unroll
        for (int ai = 0; ai < 2; ++ai)
#pragma unroll
            for (int m = 0; m < 4; ++m) {
                const int rt = ai * HALF + wr * 64 + m * 16 + fr;
                f32x4 v[2][2];
#pragma unroll
                for (int bj = 0; bj < 2; ++bj)
#pragma unroll
                    for (int n = 0; n < 2; ++n) v[bj][n] = acc[ai][bj][m][n];
                if (hh >= 28) {
#pragma unroll
                    for (int n = 0; n < 2; ++n)
#pragma unroll
                        for (int e = 0; e < 4; ++e) { const float ea = __builtin_amdgcn_exp2f(fminf(-1.4426950408889634f * v[0][n][e], 60.f)), eb = __builtin_amdgcn_exp2f(fminf(-1.4426950408889634f * v[1][n][e], 60.f));
                            v[0][n][e] = (1.0f + eb) * fast_rcp(1.0f + ea); v[1][n][e] = fast_rcp(1.0f + eb); }
                } else if (hh >= 12) {
#pragma unroll
                    for (int bj = 0; bj < 2; ++bj)
#pragma unroll
                        for (int n = 0; n < 2; ++n)
#pragma unroll
                            for (int e = 0; e < 4; ++e) v[bj][n][e] = gelu_fast(v[bj][n][e]);
                }
                if (is_k || is_q || is_vg) {
                    float s = 0.f;
#pragma unroll
                    for (int bj = 0; bj < 2; ++bj)
#pragma unroll
                        for (int n = 0; n < 2; ++n) { const f32x4 x = v[bj][n]; s += (x[0] * x[0] + x[1] * x[1]) + (x[2] * x[2] + x[3] * x[3]); }
                    s += __shfl_xor(s, 16); s += __shfl_xor(s, 32);
                    const float rstd = __builtin_amdgcn_rsqf(s * (1.0f / 64.0f) + EPS);
#pragma unroll
                    for (int bj = 0; bj < 2; ++bj)
#pragma unroll
                        for (int n = 0; n < 2; ++n) v[bj][n] = v[bj][n] * rstd * gv[bj][n];
                    if ((is_k || is_q) && !ctx) {
                        const int prow = (4 * u.pm + 2 * ai + wr) & 127, pcol = m * 16 + fr;
                        const float* tp = rope + (fq < 2 ? prow : pcol) * 32 + 8 * (fq & 1);
#pragma unroll
                        for (int n = 0; n < 2; ++n) { const f32x4 cs = *(const f32x4*)(tp + 4 * n), sn = *(const f32x4*)(tp + 16 + 4 * n);
                            const f32x4 x1 = v[0][n], x2 = v[1][n]; v[0][n] = x1 * cs - x2 * sn; v[1][n] = x2 * cs + x1 * sn; }
                    }
                    if (is_q) {
#pragma unroll
                        for (int bj = 0; bj < 2; ++bj)
#pragma unroll
                            for (int n = 0; n < 2; ++n) v[bj][n] = v[bj][n] * QSCALE_LOG2E;
                    }
                }
                if (is_k || is_q) {
                    unsigned char* p8 = (is_k ? K8 + hh * 64 + (rowbase + rt) * (size_t)128 : Q8 + (hh - 4) * 64 + (rowbase + rt) * (size_t)512) + dl;
#pragma unroll
                    for (int bj = 0; bj < 2; ++bj) { int lo = __builtin_amdgcn_cvt_pk_fp8_f32(v[bj][0][0], v[bj][0][1], 0, false); lo = __builtin_amdgcn_cvt_pk_fp8_f32(v[bj][0][2], v[bj][0][3], lo, true);
                        int hi2 = __builtin_amdgcn_cvt_pk_fp8_f32(v[bj][1][0], v[bj][1][1], 0, false); hi2 = __builtin_amdgcn_cvt_pk_fp8_f32(v[bj][1][2], v[bj][1][3], hi2, true);
                        u32x2 w8; w8.x = (unsigned)lo; w8.y = (unsigned)hi2; *(u32x2*)(p8 + 32 * bj) = w8; }
                }
                if (hh == 2 || hh == 3) {
                    const int kk = m * 16 + fr, p8 = 32 * ((kk >> 2) & 1) + (kk & 3) + 4 * ((kk & 31) >> 3) + 16 * (kk >> 5);
                    const size_t tile = (ctx ? (size_t)(u.pm - 128) * 264 : (size_t)(u.pm >> 5) * 264 + 4 + 4 * (u.pm & 31)) + (size_t)(hh - 2) * 132 + 2 * ai + wr;
                    unsigned char* vt = V8T + tile * 4096 + p8;
#pragma unroll
                    for (int bj = 0; bj < 2; ++bj)
#pragma unroll
                        for (int n = 0; n < 2; ++n) { const int w01 = __builtin_amdgcn_cvt_pk_fp8_f32(v[bj][n][0], v[bj][n][1], 0, false), w23 = __builtin_amdgcn_cvt_pk_fp8_f32(v[bj][n][2], v[bj][n][3], 0, false);
                            unsigned char* q = vt + (32 * bj + dl + 4 * n) * 64;
                            q[0] = (unsigned char)(w01 & 0xff); q[64] = (unsigned char)((w01 >> 8) & 0xff); q[128] = (unsigned char)(w23 & 0xff); q[192] = (unsigned char)((w23 >> 8) & 0xff); }
                }
                bf16_t* rowp = dbase + (rowbase + rt) * pitch + dl;
                if (!(skip16 && hh < 12))
#pragma unroll
                for (int bj = 0; bj < 2; ++bj) { u32x4 w; w.x = cvt_pk_bf16(v[bj][0][0], v[bj][0][1]); w.y = cvt_pk_bf16(v[bj][0][2], v[bj][0][3]); w.z = cvt_pk_bf16(v[bj][1][0], v[bj][1][1]); w.w = cvt_pk_bf16(v[bj][1][2], v[bj][1][3]);
                    *(u32x4*)(rowp + (hh >= 28 ? (GBb - GAb) * bj : 32 * bj)) = w; }
            }
    }
};
struct EpiMerge {
    static constexpr bool PERM = true, AFTER_DRAIN = false; static constexpr int NST = 0;
    const bf16_t *GAb, *GBb; bf16_t* Y;
    __device__ __forceinline__ void operator()(f32x4 (&acc)[2][2][4][2], const Unit& u, int wr, int wc, int fr, int fq) const {
        const int row0 = u.pm * BM + wr * 64 + fr, col0 = u.pn * BM + wc * 32 + 8 * fq;
#pragma unroll
        for (int ai = 0; ai < 2; ++ai) {
            u32x4 gb[4][2], ga[4][2];
#pragma unroll
            for (int m = 0; m < 4; ++m)
#pragma unroll
                for (int bj = 0; bj < 2; ++bj) { const size_t off = (size_t)(row0 + ai * HALF + m * 16) * 1024 + col0 + bj * HALF; if (u.keep) ga[m][bj] = *(const u32x4*)(GAb + off); else gb[m][bj] = *(const u32x4*)(GBb + off); }
            asm volatile("" ::: "memory");
#pragma unroll
            for (int m = 0; m < 4; ++m)
#pragma unroll
                for (int bj = 0; bj < 2; ++bj) { const size_t off = (size_t)(row0 + ai * HALF + m * 16) * 1024 + col0 + bj * HALF;
                    if (u.keep) {
#pragma unroll
                        for (int k = 0; k < 4; ++k) { const int n = k >> 1, e = (k & 1) * 2;
                            acc[ai][bj][m][n][e] *= bf_lo(ga[m][bj][k]); acc[ai][bj][m][n][e + 1] *= bf_hi(ga[m][bj][k]); }
                    } else { u32x4 w;
#pragma unroll
                        for (int k = 0; k < 4; ++k) { const int n = k >> 1, e = (k & 1) * 2; w[k] = cvt_pk_bf16(acc[ai][bj][m][n][e] * bf_lo(gb[m][bj][k]), acc[ai][bj][m][n][e + 1] * bf_hi(gb[m][bj][k])); }
                        *(u32x4*)(Y + off) = w; }
                }
            asm volatile("" ::: "memory");
        }
    }
};
struct EpiOutProj {
    static constexpr bool PERM = true, AFTER_DRAIN = false; static constexpr int NST = 16;
    const float* x; bf16_t* X1b; float* ssq; const float* mod;
    __device__ __forceinline__ void operator()(f32x4 (&acc)[2][2][4][2], const Unit& u, int wr, int wc, int fr, int fq) const {
        const int row0 = u.pm * BM + wr * 64 + fr, col0 = u.pn * BM + wc * 32 + 8 * fq;
        const float* mv = mod + (size_t)(u.pm >> 5) * NMOD;
        {
            f32x4 g1v[2][2];
#pragma unroll
            for (int bj = 0; bj < 2; ++bj)
#pragma unroll
                for (int n = 0; n < 2; ++n) g1v[bj][n] = *(const f32x4*)(mv + 2 * DM + col0 + bj * HALF + n * 4);
#pragma unroll
            for (int ai = 0; ai < 2; ++ai)
#pragma unroll
                for (int m = 0; m < 4; ++m)
#pragma unroll
                    for (int bj = 0; bj < 2; ++bj)
#pragma unroll
                        for (int n = 0; n < 2; ++n) acc[ai][bj][m][n] *= g1v[bj][n];
        }
        asm volatile("" ::: "memory");
#pragma unroll
        for (int ai = 0; ai < 2; ++ai) {
            f32x4 pre[4][2][2];
#pragma unroll
            for (int m = 0; m < 4; ++m)
#pragma unroll
                for (int bj = 0; bj < 2; ++bj)
#pragma unroll
                    for (int n = 0; n < 2; ++n) pre[m][bj][n] = *(const f32x4*)(x + (size_t)(row0 + ai * HALF + m * 16) * DM + col0 + bj * HALF + n * 4);
            asm volatile("" ::: "memory");
#pragma unroll
            for (int m = 0; m < 4; ++m) { const int r = row0 + ai * HALF + m * 16; bf16_t* op = X1b + (size_t)r * DM + col0; float s = 0.f;
#pragma unroll
                for (int bj = 0; bj < 2; ++bj) { const f32x4 a0 = pre[m][bj][0] + acc[ai][bj][m][0], a1 = pre[m][bj][1] + acc[ai][bj][m][1];
                    s += ((a0[0] * a0[0] + a0[1] * a0[1]) + (a0[2] * a0[2] + a0[3] * a0[3])) + ((a1[0] * a1[0] + a1[1] * a1[1]) + (a1[2] * a1[2] + a1[3] * a1[3]));
                    u32x4 w; w.x = cvt_pk_bf16(a0[0], a0[1]); w.y = cvt_pk_bf16(a0[2], a0[3]); w.z = cvt_pk_bf16(a1[0], a1[1]); w.w = cvt_pk_bf16(a1[2], a1[3]);
                    *(u32x4*)(op + bj * HALF) = w; }
                s += __shfl_xor(s, 16); s += __shfl_xor(s, 32);
                if (fq == 0) ssq[(size_t)r * 16 + u.pn * 4 + wc] = s; }
            asm volatile("" ::: "memory");
        }
    }
};
struct EpiFfnUp {
    static constexpr bool PERM = true, AFTER_DRAIN = false; static constexpr int NST = 16;
    bf16_t* H; const float* ssq; const float* cvec;
    __device__ __forceinline__ void operator()(f32x4 (&acc)[2][2][4][2], const Unit& u, int wr, int wc, int fr, int fq) const {
        const int row0 = u.pm * BM + wr * 64 + fr, col0 = u.pn * BM + wc * 32 + 8 * fq;
        const float* cv = cvec + (size_t)(u.pm >> 5) * D_FF + col0;
        f32x4 bv[2][2], pp[2][4];
#pragma unroll
        for (int ai = 0; ai < 2; ++ai)
#pragma unroll
            for (int m = 0; m < 4; ++m) pp[ai][m] = *(const f32x4*)(ssq + (size_t)(row0 + ai * HALF + m * 16) * 16 + 4 * fq);
#pragma unroll
        for (int bj = 0; bj < 2; ++bj)
#pragma unroll
            for (int n = 0; n < 2; ++n) bv[bj][n] = *(const f32x4*)(cv + bj * HALF + 4 * n);
        asm volatile("" ::: "memory");
#pragma unroll
        for (int ai = 0; ai < 2; ++ai)
#pragma unroll
            for (int m = 0; m < 4; ++m) { const int r = row0 + ai * HALF + m * 16;
                const f32x4 p = pp[ai][m]; float s = (p[0] + p[1]) + (p[2] + p[3]);
                s += __shfl_xor(s, 16); s += __shfl_xor(s, 32);
                const float rstd = __builtin_amdgcn_rsqf(s * (1.0f / DM) + EPS);
                bf16_t* rowp = H + (size_t)r * D_FF + col0;
#pragma unroll
                for (int bj = 0; bj < 2; ++bj) { f32x4 v0 = acc[ai][bj][m][0] * rstd + bv[bj][0], v1 = acc[ai][bj][m][1] * rstd + bv[bj][1];
#pragma unroll
                    for (int e = 0; e < 4; ++e) { const float a = fmaxf(v0[e], 0.f), b = fmaxf(v1[e], 0.f); v0[e] = a * a; v1[e] = b * b; }
                    u32x4 w; w.x = cvt_pk_bf16(v0[0], v0[1]); w.y = cvt_pk_bf16(v0[2], v0[3]); w.z = cvt_pk_bf16(v1[0], v1[1]); w.w = cvt_pk_bf16(v1[2], v1[3]);
                    *(u32x4*)(rowp + bj * HALF) = w; } }
    }
};
struct EpiFfnDown {
    static constexpr bool PERM = true, AFTER_DRAIN = false; static constexpr int NST = 32;
    float* out; const bf16_t* X1b; const float* mod;
    __device__ __forceinline__ void operator()(f32x4 (&acc)[2][2][4][2], const Unit& u, int wr, int wc, int fr, int fq) const {
        const int row0 = u.pm * BM + wr * 64 + fr, col0 = u.pn * BM + wc * 32 + 8 * fq;
        const float* mv = mod + (size_t)(u.pm >> 5) * NMOD + 5 * DM;
        f32x4 g2v[2][2];
#pragma unroll
        for (int bj = 0; bj < 2; ++bj)
#pragma unroll
            for (int n = 0; n < 2; ++n) g2v[bj][n] = *(const f32x4*)(mv + col0 + bj * HALF + n * 4);
        u32x4 pre[2][4][2];
#pragma unroll
        for (int ai = 0; ai < 2; ++ai)
#pragma unroll
            for (int m = 0; m < 4; ++m)
#pragma unroll
                for (int bj = 0; bj < 2; ++bj) pre[ai][m][bj] = *(const u32x4*)(X1b + (size_t)(row0 + ai * HALF + m * 16) * DM + col0 + bj * HALF);
        asm volatile("" ::: "memory");
#pragma unroll
        for (int ai = 0; ai < 2; ++ai)
#pragma unroll
            for (int m = 0; m < 4; ++m) { float* op = out + (size_t)(row0 + ai * HALF + m * 16) * DM + col0;
#pragma unroll
                for (int bj = 0; bj < 2; ++bj) { const u32x4 p = pre[ai][m][bj];
                    const f32x4 r0 = (f32x4){bf_lo(p[0]), bf_hi(p[0]), bf_lo(p[1]), bf_hi(p[1])}, r1 = (f32x4){bf_lo(p[2]), bf_hi(p[2]), bf_lo(p[3]), bf_hi(p[3])};
                    *(f32x4*)(op + bj * HALF) = r0 + g2v[bj][0] * acc[ai][bj][m][0]; *(f32x4*)(op + bj * HALF + 4) = r1 + g2v[bj][1] * acc[ai][bj][m][1]; } }
    }
};

template <class Epi, class Sched, bool ALIGN_EPI, bool F8 = false>
__device__ __forceinline__ void gemm_phase(PG8_LAS unsigned char* lds, const Gemm g, const Sched& S, const Epi& E) {
    int tid_ = threadIdx.x; asm volatile("" : "+v"(tid_));
    const int tid = tid_, wid = __builtin_amdgcn_readfirstlane(tid >> 6), lane = tid & 63, wr = wid >> 2, wc = wid & 3, fr = lane & 15, fq = lane >> 4;
    const int nt = g.K / BK;
    unsigned voffA[2], voffB[2];
#pragma unroll
    for (int i = 0; i < 2; ++i) { int R, C; stage_rc(tid * 16 + i * 8192, R, C); const int Rb = Epi::PERM ? ((R & ~31) + perm32(R & 31)) : R;
        voffA[i] = (unsigned)(R * g.lda + C) * 2u; voffB[i] = (unsigned)(Rb * g.ldb + C) * 2u; }
    const size_t kstep = (size_t)(BK * 2);
    const size_t hstepA = (size_t)HALF * g.lda * 2, hstepB = (size_t)HALF * g.ldb * 2;
    const size_t tstepA = 2 * hstepA, tstepB = 2 * hstepB;
    const unsigned ldsw = (unsigned)wid * 1024u;
    const int aoff = lds_byte(wr * 64 + fr, fq * 8), boff = lds_byte(wc * 32 + fr, fq * 8);
#define PG8_SA(b, h) (((b) * 2 + (h)) * HTB)
#define PG8_SB(b, h) ((4 + (b) * 2 + (h)) * HTB)
#define PG8_STAGE(bufoff, gbase, voff) do { _Pragma("unroll") for (int _i = 0; _i < 2; ++_i) \
        __builtin_amdgcn_global_load_lds((const unsigned*)((const char*)(gbase) + (voff)[_i]), (PG8_LAS unsigned*)(lds + (bufoff) + ldsw + _i * 8192), 16, 0, 0); } while (0)
#define PG8_LDA(dst, b, h) do { _Pragma("unroll") for (int m = 0; m < 4; ++m) _Pragma("unroll") for (int k = 0; k < 2; ++k) dst[m][k] = *(const PG8_LAS bf16x8*)(lds + PG8_SA(b, h) + aoff + m * 2048 + k * 1024); } while (0)
#define PG8_LDB(dst, b, h) do { _Pragma("unroll") for (int n = 0; n < 2; ++n) _Pragma("unroll") for (int k = 0; k < 2; ++k) dst[n][k] = *(const PG8_LAS bf16x8*)(lds + PG8_SB(b, h) + boff + n * 2048 + k * 1024); } while (0)
#define PG8_CAT(x0, x1) __builtin_shufflevector(__builtin_bit_cast(v4i_t, x0), __builtin_bit_cast(v4i_t, x1), 0, 1, 2, 3, 4, 5, 6, 7)
#define PG8_MMA(ai, bj, At, Bt) do { __builtin_amdgcn_s_setprio(1); \
        if constexpr (F8) { _Pragma("unroll") for (int m = 0; m < 4; ++m) _Pragma("unroll") for (int n = 0; n < 2; ++n) \
            asm volatile("v_mfma_f32_16x16x128_f8f6f4 %0, %1, %2, %0" : "+v"(acc[ai][bj][m][n]) : "v"(PG8_CAT(Bt[n][0], Bt[n][1])), "v"(PG8_CAT(At[m][0], At[m][1]))); }   \
        else { _Pragma("unroll") for (int m = 0; m < 4; ++m) _Pragma("unroll") for (int n = 0; n < 2; ++n) _Pragma("unroll") for (int k = 0; k < 2; ++k) \
            acc[ai][bj][m][n] = __builtin_amdgcn_mfma_f32_16x16x32_bf16(Bt[n][k], At[m][k], acc[ai][bj][m][n], 0, 0, 0); } \
        __builtin_amdgcn_s_setprio(0); } while (0)
#define PG8_WAIT_V(n) asm volatile("s_waitcnt vmcnt(" #n ")" ::: "memory")
#define PG8_WAIT_L(n) asm volatile("s_waitcnt lgkmcnt(" #n ")" ::: "memory")
#define PG8_BAR __builtin_amdgcn_s_barrier()
#define PG8_SCHED __builtin_amdgcn_sched_barrier(0)
    Unit cur, nxt; int ui = 0;
    if (!S.next(0, cur)) return;
    f32x4 acc[2][2][4][2];
#pragma unroll
    for (int a = 0; a < 2; ++a)
#pragma unroll
        for (int b = 0; b < 2; ++b)
#pragma unroll
            for (int m = 0; m < 4; ++m)
#pragma unroll
                for (int n = 0; n < 2; ++n) acc[a][b][m][n] = (f32x4){0.f, 0.f, 0.f, 0.f};
    bf16x8 At[4][2], B0[2][2], B1[2][2];
    const char* cA = (const char*)g.A + (size_t)cur.pm * tstepA + (size_t)cur.ko * 2; const char* cB = (const char*)g.Bt + (size_t)cur.pn * tstepB + (size_t)cur.ko * 2 + cur.bofs;
    PG8_STAGE(PG8_SB(0, 0), cB, voffB); PG8_STAGE(PG8_SB(0, 1), cB + hstepB, voffB); PG8_STAGE(PG8_SA(0, 0), cA, voffA); PG8_STAGE(PG8_SA(0, 1), cA + hstepA, voffA);
    if (wr == 1) PG8_BAR;
    PG8_WAIT_V(2); PG8_BAR;
    PG8_STAGE(PG8_SB(1, 0), cB + kstep, voffB); PG8_STAGE(PG8_SA(1, 0), cA + kstep, voffA); PG8_STAGE(PG8_SB(1, 1), cB + hstepB + kstep, voffB);
    PG8_WAIT_V(6); PG8_BAR;
    for (;;) {
        const bool has_next = S.next(ui + 1, nxt);
        const char* nA = has_next ? (const char*)g.A + (size_t)nxt.pm * tstepA + (size_t)nxt.ko * 2 : cA; const char* nB = has_next ? (const char*)g.Bt + (size_t)nxt.pn * tstepB + (size_t)nxt.ko * 2 + nxt.bofs : cB;
#define PG8_WAITR(PRE) do { if (PRE) { if constexpr (Epi::NST >= 32) PG8_WAIT_V(40); else if constexpr (Epi::NST >= 16) PG8_WAIT_V(24); else PG8_WAIT_V(8); } else PG8_WAIT_V(8); } while (0)
#define PG8_ITER(t, PRE) do { \
            const bool last = ((t) == nt - 2); \
            const char* a1 = cA + (size_t)((t) + 1) * kstep; \
            const char* a2 = last ? nA : cA + (size_t)((t) + 2) * kstep; const char* b2 = last ? nB : cB + (size_t)((t) + 2) * kstep; \
            const char* a3 = a2 + kstep; const char* b3 = b2 + kstep; \
              \
            PG8_LDB(B0, 0, 0); PG8_LDB(B1, 0, 1); PG8_SCHED; PG8_LDA(At, 0, 0); if (!(PRE)) PG8_STAGE(PG8_SA(1, 1), a1 + hstepA, voffA); \
            PG8_WAITR(PRE); PG8_WAIT_L(0); PG8_BAR; PG8_MMA(0, 0, At, B0); PG8_MMA(0, 1, At, B1); PG8_BAR; PG8_SCHED; \
              \
            PG8_LDA(At, 0, 1); PG8_STAGE(PG8_SB(0, 0), b2, voffB); PG8_STAGE(PG8_SB(0, 1), b2 + hstepB, voffB); PG8_STAGE(PG8_SA(0, 0), a2, voffA); \
            PG8_WAITR(PRE); PG8_WAIT_L(0); PG8_BAR; PG8_MMA(1, 0, At, B0); PG8_MMA(1, 1, At, B1); PG8_BAR; PG8_SCHED; \
              \
            PG8_LDB(B0, 1, 0); PG8_LDB(B1, 1, 1); PG8_SCHED; PG8_LDA(At, 1, 0); PG8_STAGE(PG8_SA(0, 1), a2 + hstepA, voffA); \
            PG8_WAITR(PRE); PG8_WAIT_L(0); PG8_BAR; PG8_MMA(0, 0, At, B0); PG8_MMA(0, 1, At, B1); PG8_BAR; PG8_SCHED; \
              \
            PG8_LDA(At, 1, 1); PG8_STAGE(PG8_SB(1, 0), b3, voffB); PG8_STAGE(PG8_SB(1, 1), b3 + hstepB, voffB); PG8_STAGE(PG8_SA(1, 0), a3, voffA); \
            PG8_WAIT_V(8); PG8_WAIT_L(0); PG8_BAR; PG8_MMA(1, 0, At, B0); PG8_MMA(1, 1, At, B1); PG8_BAR; PG8_SCHED; \
        } while (0)
        constexpr bool RELAX = ALIGN_EPI && Epi::NST > 0;
#pragma unroll 1
        for (int t = 0; t < nt; t += 2) { const bool pre = RELAX && ui > 0 && t == 0; PG8_ITER(t, pre); }
        if constexpr (ALIGN_EPI) { if (wr == 0) PG8_BAR; }
        if (RELAX && has_next) PG8_STAGE(PG8_SA(1, 1), nA + kstep + hstepA, voffA);
        if constexpr (F8) asm volatile("s_nop 15\n\ts_nop 7" ::: "memory");
        { int fr_e = fr, fq_e = fq; asm volatile("" : "+v"(fr_e), "+v"(fq_e));
          E(acc, cur, wr, wc, fr_e, fq_e); }
        if (!has_next) break;
        if (!cur.keep) {
#pragma unroll
            for (int a = 0; a < 2; ++a)
#pragma unroll
                for (int b = 0; b < 2; ++b)
#pragma unroll
                    for (int m = 0; m < 4; ++m)
#pragma unroll
                        for (int n = 0; n < 2; ++n) acc[a][b][m][n] = (f32x4){0.f, 0.f, 0.f, 0.f};
        }
        cur = nxt; cA = nA; cB = nB; ++ui;
        if constexpr (ALIGN_EPI) { if (wr == 1) PG8_BAR; }
    }
    PG8_WAIT_V(0);
    if constexpr (!ALIGN_EPI) { if (wr == 0) PG8_BAR; }
    PG8_BAR;
#undef PG8_SA
#undef PG8_SB
#undef PG8_STAGE
#undef PG8_LDA
#undef PG8_LDB
#undef PG8_MMA
#undef PG8_ITER
#undef PG8_WAITR
#undef PG8_CAT
#undef PG8_WAIT_V
#undef PG8_WAIT_L
#undef PG8_BAR
#undef PG8_SCHED
}
}
#include <hip/hip_bf16.h>
#include <cmath>
namespace attn_body {
using bf16=__hip_bfloat16;
using bf16x8=__attribute__((ext_vector_type(8)))short;
using s16x4=__attribute__((ext_vector_type(4)))short;
using f32x16=__attribute__((ext_vector_type(16)))float;
using u32x4=__attribute__((ext_vector_type(4)))unsigned;
constexpr int SEQ=8192,D=64,QP=512,KP=128,OP=1024,NKEYS=8448;
constexpr int NW=8,QBLK=32,QB=QBLK*NW,KVBLK=64,NQB=SEQ/QB;
constexpr int ATTN_UNIT_ROWS=QB;
__device__ __forceinline__ int crow(int r,int hi){return (r&3)+8*(r>>2)+4*hi;}
#define SBAR() __builtin_amdgcn_sched_barrier(0)
__device__ __forceinline__ void cmask(f32x16&p0,f32x16&p1,int jb,int qrel,int hi){
  const float NEG=-INFINITY; int kb=64*jb+4*hi;
  #pragma unroll
  for(int r=0;r<16;++r){int kv=kb+(r&3)+8*(r>>2); if(kv>qrel)p0[r]=NEG; if(kv+32>qrel)p1[r]=NEG;}
}

constexpr int NSLOT=3, SLOTB=8192;
constexpr int LDS_K=0, LDS_V=NSLOT*SLOTB, LDS_WS=2*NSLOT*SLOTB, LDS_OST=LDS_WS+NW*64*4, LDS_BYTES=LDS_OST+NW*4096;
constexpr float C2=0.125f*1.4426950408889634f;
__device__ __forceinline__ void glds16(const void*gsrc,unsigned lds_dst){unsigned keep;
  asm volatile("s_mov_b32 %0, m0\n\ts_mov_b32 m0, %2\n\ts_nop 0\n\tglobal_load_lds_dwordx4 %1, off\n\ts_mov_b32 m0, %0":"=&s"(keep):"v"(gsrc),"s"(lds_dst):"memory");}
__device__ __forceinline__ float max3f(float a,float b,float c){float r;asm("v_max3_f32 %0, %1, %2, %3":"=v"(r):"v"(a),"v"(b),"v"(c));return r;}
__device__ __forceinline__ float max2f(float a,float b){float r;asm("v_max_f32_e32 %0, %1, %2":"=v"(r):"v"(a),"v"(b));return r;}
__device__ __forceinline__ float fadd_s(float a,float b){float r;asm("v_add_f32_e32 %0, %1, %2":"=v"(r):"v"(a),"v"(b));return r;}
__device__ __forceinline__ float fsub_s(float a,float b){float r;asm("v_sub_f32_e32 %0, %1, %2":"=v"(r):"v"(a),"v"(b));return r;}
typedef float f32x2_t __attribute__((ext_vector_type(2))); typedef __bf16 bf16x2_t __attribute__((ext_vector_type(2)));
__device__ __forceinline__ unsigned cvtpk_s(float lo,float hi){f32x2_t v={lo,hi};bf16x2_t b=__builtin_convertvector(v,bf16x2_t);return __builtin_bit_cast(unsigned,b);}
#define WAIT_BAR(N) asm volatile("s_waitcnt vmcnt(" #N ") lgkmcnt(0)\n\ts_barrier":::"memory")

__device__ __forceinline__ void qkt(f32x16&p0,f32x16&p1,const char*Kslot,const bf16x8*qr,const f32x16&negm,int r32,int hi){
  const char*kb=Kslot+hi*1024+r32*16;
  #pragma unroll
  for(int d0=0;d0<4;++d0){
    const bf16x8 b0=*reinterpret_cast<const bf16x8*>(kb+d0*2048);
    const bf16x8 b1=*reinterpret_cast<const bf16x8*>(kb+d0*2048+512);
    if(d0==0){p0=__builtin_amdgcn_mfma_f32_32x32x16_bf16(b0,qr[0],negm,0,0,0);p1=__builtin_amdgcn_mfma_f32_32x32x16_bf16(b1,qr[0],negm,0,0,0);}
    else{p0=__builtin_amdgcn_mfma_f32_32x32x16_bf16(b0,qr[d0],p0,0,0,0);p1=__builtin_amdgcn_mfma_f32_32x32x16_bf16(b1,qr[d0],p1,0,0,0);}}
}
typedef __attribute__((address_space(3))) const char* lds_cptr;
typedef short v4i16_t __attribute__((ext_vector_type(4)));
__device__ __forceinline__ void kload8(bf16x8*kf,lds_cptr kp){
  kf[0]=*(const __attribute__((address_space(3))) bf16x8*)(kp);      kf[1]=*(const __attribute__((address_space(3))) bf16x8*)(kp+512);
  kf[2]=*(const __attribute__((address_space(3))) bf16x8*)(kp+2048); kf[3]=*(const __attribute__((address_space(3))) bf16x8*)(kp+2560);
  kf[4]=*(const __attribute__((address_space(3))) bf16x8*)(kp+4096); kf[5]=*(const __attribute__((address_space(3))) bf16x8*)(kp+4608);
  kf[6]=*(const __attribute__((address_space(3))) bf16x8*)(kp+6144); kf[7]=*(const __attribute__((address_space(3))) bf16x8*)(kp+6656);
}
__device__ __forceinline__ void kload2(bf16x8*kf,lds_cptr kp,int j){ kf[2*j]=*(const __attribute__((address_space(3))) bf16x8*)(kp+j*2048); kf[2*j+1]=*(const __attribute__((address_space(3))) bf16x8*)(kp+j*2048+512); }
__device__ __forceinline__ s16x4 vtr(lds_cptr p){ return __builtin_bit_cast(s16x4,__builtin_amdgcn_ds_read_tr16_b64_v4i16((__attribute__((address_space(3))) v4i16_t*)p)); }
__device__ __forceinline__ float rowmax(const f32x16&p0,const f32x16&p1){
  float a=max3f(p0[0],p0[1],p1[0]),b=max3f(p0[2],p0[3],p1[1]);a=max3f(a,p1[2],p1[3]);
  #pragma unroll
  for(int r=4;r<16;r+=4){a=max3f(a,p0[r],p0[r+1]);b=max3f(b,p0[r+2],p0[r+3]);a=max3f(a,p1[r],p1[r+1]);b=max3f(b,p1[r+2],p1[r+3]);}
  const float m=max2f(a,b);
  auto rr=__builtin_amdgcn_permlane32_swap(__float_as_uint(m),__float_as_uint(m),false,false);
  return max2f(__uint_as_float(rr[0]),__uint_as_float(rr[1]));
}
__device__ __forceinline__ void pv(f32x16*o,int vb,bf16x8 pa0,bf16x8 pa1,bf16x8 pa2,bf16x8 pa3){
  #pragma unroll
  for(int d0=0;d0<2;++d0){s16x4 lo[4],hi[4];
    #pragma unroll
    for(int ks=0;ks<4;++ks){
      asm volatile("ds_read_b64_tr_b16 %0,%1 offset:%c2":"=&v"(lo[ks]):"v"(vb),"i"(d0*4096+ks*1024):"memory");
      asm volatile("ds_read_b64_tr_b16 %0,%1 offset:%c2":"=&v"(hi[ks]):"v"(vb),"i"(d0*4096+ks*1024+512):"memory");}
    asm volatile("s_waitcnt lgkmcnt(0)":::"memory");SBAR();
    #define PK(k) (bf16x8){lo[k][0],lo[k][1],lo[k][2],lo[k][3],hi[k][0],hi[k][1],hi[k][2],hi[k][3]}
    o[d0]=__builtin_amdgcn_mfma_f32_32x32x16_bf16(pa0,PK(0),o[d0],0,0,0);
    o[d0]=__builtin_amdgcn_mfma_f32_32x32x16_bf16(pa1,PK(1),o[d0],0,0,0);
    o[d0]=__builtin_amdgcn_mfma_f32_32x32x16_bf16(pa2,PK(2),o[d0],0,0,0);
    o[d0]=__builtin_amdgcn_mfma_f32_32x32x16_bf16(pa3,PK(3),o[d0],0,0,0);
    #undef PK
  }
}

#ifndef ATTN_STORE16
#define ATTN_STORE16(p,v) (*(u32x4*)(p)=(v))
#endif
template<int THRL,bool NOREF,int ABL=0> __device__ __forceinline__ void attn_unit(int b,int h,int qb,const bf16*Q,const bf16*__restrict__ K,const bf16*__restrict__ V,bf16*O,char*shm){
  int tid_=threadIdx.x; asm volatile("":"+v"(tid_)); const int tid=tid_,lane=tid&63,r32=lane&31,hi=lane>>5; const int wid=__builtin_amdgcn_readfirstlane(tid>>6);
  const long rowbase=(long)b*SEQ; const int q0=qb*QB;
  const bf16*Qw=Q+(rowbase+q0+wid*QBLK)*QP+h*D;
  const bf16*Kh=K+(long)b*NKEYS*KP+(h>>2)*D,*Vh=V+(long)b*NKEYS*KP+(h>>2)*D;
  const unsigned lds0=(unsigned)(uintptr_t)shm;
  float*wsf=(float*)(shm+LDS_WS)+wid*64;
  const bf16*ksrc=Kh+(long)lane*KP+wid*8;
  const bf16*vsrc=Vh+(long)(16*(wid&3)+(lane>>2))*KP+(wid>>2)*32+(lane&3)*8;
  const unsigned kdst=lds0+LDS_K+wid*1024, vdst=lds0+LDS_V+wid*1024;
  #define DMA_K(t,slot) glds16(ksrc+(long)(t)*KVBLK*KP,(unsigned)__builtin_amdgcn_readfirstlane(kdst+(slot)))
  #define DMA_V(t,slot) glds16(vsrc+(long)(t)*KVBLK*KP,(unsigned)__builtin_amdgcn_readfirstlane(vdst+(slot)))
  const int vb0=(int)(lds0+LDS_V)+((lane>>4)&1)*32+(lane&3)*8+(4*hi+((lane&15)>>2))*64;
  const char*Kbase=shm+LDS_K; bf16x8 kf[8];
  const lds_cptr shm3=(lds_cptr)shm; const lds_cptr kp0=shm3+LDS_K+hi*1024+r32*16; const lds_cptr vp0=shm3+LDS_V+((lane>>4)&1)*32+(lane&3)*8+(4*hi+((lane&15)>>2))*64;
  constexpr int NT=NKEYS/KVBLK;
  DMA_K(0,0);DMA_V(0,0);DMA_K(1,SLOTB);
  bf16x8 qr[4];
  #pragma unroll
  for(int d0=0;d0<4;++d0)qr[d0]=*reinterpret_cast<const bf16x8*>(&Qw[(long)r32*QP+d0*16+hi*8]);
  float mhat=0.f,l_reg=0.f;f32x16 o[2];o[0]=f32x16{};o[1]=f32x16{};f32x16 negm=f32x16{};asm volatile("":"+v"(negm));
  #define CMASK(P0,P1,t) do{}while(0)
  bool resc=false;
  #define START(P0,P1) do{ if constexpr(!NOREF){ const float rm=rowmax(P0,P1); resc=false; \
    { const float dl=rm; mhat=fadd_s(mhat,dl); \
      _Pragma("unroll") for(int r=0;r<16;++r){P0[r]=fsub_s(P0[r],dl);P1[r]=fsub_s(P1[r],dl);} \
      _Pragma("unroll") for(int r=0;r<16;++r)negm[r]=-mhat; asm volatile("":"+v"(negm)); } } \
    _Pragma("unroll") for(int r=0;r<16;++r)P0[r]=__builtin_amdgcn_exp2f(P0[r]); }while(0)
  #define RESC() do{ if constexpr(!NOREF) if(resc){ asm volatile("s_waitcnt lgkmcnt(0)":::"memory"); \
      _Pragma("unroll") for(int d_=0;d_<2;++d_) _Pragma("unroll") for(int r=0;r<16;++r)o[d_][r]*=wsf[crow(r,hi)]; } }while(0)
  f32x16 pA0,pA1,pB0,pB1;
  int sl_prev=0,sl_cur=0,sl_next=SLOTB;
  #define ROT() do{sl_prev=sl_cur;sl_cur=sl_next;sl_next=(sl_next==(NSLOT-1)*SLOTB)?0:sl_next+SLOTB;}while(0)
  DMA_K(2,2*SLOTB);
  WAIT_BAR(3);
  qkt(pA0,pA1,Kbase,qr,negm,r32,hi);asm volatile("s_nop 15\n\ts_nop 7":"+v"(pA0),"+v"(pA1));CMASK(pA0,pA1,0);
  START(pA0,pA1);
  _Pragma("unroll") for(int r=0;r<16;++r)pA1[r]=__builtin_amdgcn_exp2f(pA1[r]);
  WAIT_BAR(0);
  DMA_K(3,0);DMA_V(1,SLOTB);
  ROT();
  kload8(kf,kp0+sl_cur);
  WAIT_BAR(2);
  s16x4 vlo[8],vhi[8]; u32x4 pw0,pw1,pw2,pw3;
  #define PKW(P,B) cvtpk_s(P[B],P[B+1])
  #define PAF(k) __builtin_bit_cast(bf16x8,pw##k)
  #define VFR(i) (bf16x8){vlo[i][0],vlo[i][1],vlo[i][2],vlo[i][3],vhi[i][0],vhi[i][1],vhi[i][2],vhi[i][3]}
  #define PIN(x) asm volatile("":"+v"(x))
  #define MX3(a,b,c) __builtin_fmaxf(__builtin_fmaxf((a),(b)),(c))
  #define GAPA(MF,A0,A1,A2,A3,W0,W1,PW) do{ MF; if constexpr(ABL!=2){ sacc+=A0; sacc+=A1; sacc+=A2; sacc+=A3; PIN(sacc); W0; W1; PIN(PW); } SBAR(); }while(0)
  #define EX(v) (ABL==1?(v):__builtin_amdgcn_exp2f(v))
  #define GAPB(MF,X,B) do{ MF; X[B]=EX(X[B]); X[B+1]=EX(X[B+1]); X[B+2]=EX(X[B+2]); X[B+3]=EX(X[B+3]); PIN(X); SBAR(); }while(0)
  #define VRD(i) do{ if constexpr(ABL!=3){ vlo[i]=vtr(vp_+(((i)>>2)*4096+((i)&3)*1024)); vhi[i]=vtr(vp_+(((i)>>2)*4096+((i)&3)*1024+512)); } }while(0)
  #define KRD(G,j) do{ if constexpr(ABL!=4){ if(G){ kload2(kf,kp0+sl_next,j); SBAR(); } } }while(0)
  #define AMFMA(a,b,c,x,y,z) (ABL==6?(c):__builtin_amdgcn_mfma_f32_32x32x16_bf16(a,b,c,x,y,z))
  #define STEP(C0,C1,P0,P1,t,GK,GV,GL) do{ SBAR(); \
    const lds_cptr vp_=vp0+sl_prev; \
    VRD(0); SBAR(); float sacc=(P0[0]+P0[1]); \
    GAPA(C0=AMFMA(kf[0],qr[0],negm,0,0,0), P0[2],P0[3],P0[4],P0[5],     pw0[0]=PKW(P0,0), pw0[1]=PKW(P0,2), pw0); \
    VRD(4); SBAR(); GAPA(C1=AMFMA(kf[1],qr[0],negm,0,0,0), P0[6],P0[7],P0[8],P0[9],     pw0[2]=PKW(P0,4), pw0[3]=PKW(P0,6), pw0); \
    VRD(1); SBAR(); GAPA(C0=AMFMA(kf[2],qr[1],C0,0,0,0),   P0[10],P0[11],P0[12],P0[13], pw1[0]=PKW(P0,8), pw1[1]=PKW(P0,10), pw1); \
    VRD(5); SBAR(); GAPA(C1=AMFMA(kf[3],qr[1],C1,0,0,0),   P0[14],P0[15],P1[0],P1[1],   pw1[2]=PKW(P0,12),pw1[3]=PKW(P0,14), pw1); \
    VRD(2); SBAR(); GAPA(C0=AMFMA(kf[4],qr[2],C0,0,0,0),   P1[2],P1[3],P1[4],P1[5],     pw2[0]=PKW(P1,0), pw2[1]=PKW(P1,2), pw2); \
    VRD(6); SBAR(); GAPA(C1=AMFMA(kf[5],qr[2],C1,0,0,0),   P1[6],P1[7],P1[8],P1[9],     pw2[2]=PKW(P1,4), pw2[3]=PKW(P1,6), pw2); \
    VRD(3); SBAR(); GAPA(C0=AMFMA(kf[6],qr[3],C0,0,0,0),   P1[10],P1[11],P1[12],P1[13], pw3[0]=PKW(P1,8), pw3[1]=PKW(P1,10), pw3); \
    VRD(7); SBAR(); GAPA(C1=AMFMA(kf[7],qr[3],C1,0,0,0),   P1[14],P1[15],0.f,0.f,       pw3[2]=PKW(P1,12),pw3[3]=PKW(P1,14), pw3); \
    l_reg+=sacc; \
    if constexpr(ABL!=7){ if(GK){DMA_K((t)+3,sl_cur);} if(GV){DMA_V((t)+1,sl_next);} } \
    CMASK(C0,C1,t); \
    if constexpr(!NOREF){ float a=MX3(C0[0],C0[1],C1[0]),b=MX3(C0[2],C0[3],C1[1]); a=MX3(a,C1[2],C1[3]); \
      _Pragma("unroll") for(int r=4;r<16;r+=4){a=MX3(a,C0[r],C0[r+1]);b=MX3(b,C0[r+2],C0[r+3]);a=MX3(a,C1[r],C1[r+1]);b=MX3(b,C1[r+2],C1[r+3]);} \
      float rm=__builtin_fmaxf(a,b); { auto rr=__builtin_amdgcn_permlane32_swap(__float_as_uint(rm),__float_as_uint(rm),false,false); rm=__builtin_fmaxf(__uint_as_float(rr[0]),__uint_as_float(rr[1])); } \
      resc=false; \
      if(__builtin_expect(__any(rm>(float)THRL),0)){ const float dl=__builtin_fmaxf(rm,0.f); mhat+=dl; \
        _Pragma("unroll") for(int r=0;r<16;++r){C0[r]-=dl;C1[r]-=dl;} \
        _Pragma("unroll") for(int r=0;r<16;++r)negm[r]=-mhat; asm volatile("":"+v"(negm)); \
        const float f=__builtin_amdgcn_exp2f(-dl); l_reg*=f; if(hi==0)wsf[r32]=f; resc=true; } } \
    SBAR(); \
    GAPB(o[0]=AMFMA(PAF(0),VFR(0),o[0],0,0,0), C0,0); \
    GAPB(o[1]=AMFMA(PAF(0),VFR(4),o[1],0,0,0), C0,4); \
    KRD(GL,0); GAPB(o[0]=AMFMA(PAF(1),VFR(1),o[0],0,0,0), C0,8); \
    KRD(GL,1); GAPB(o[1]=AMFMA(PAF(1),VFR(5),o[1],0,0,0), C0,12); \
    KRD(GL,2); GAPB(o[0]=AMFMA(PAF(2),VFR(2),o[0],0,0,0), C1,0); \
    KRD(GL,3); GAPB(o[1]=AMFMA(PAF(2),VFR(6),o[1],0,0,0), C1,4); \
    GAPB(o[0]=AMFMA(PAF(3),VFR(3),o[0],0,0,0), C1,8); \
    GAPB(o[1]=AMFMA(PAF(3),VFR(7),o[1],0,0,0), C1,12); \
    }while(0)
  int t=1;
  #undef CMASK
  #define CMASK(P0,P1,t) do{}while(0)
  for(;t+5<NT;t+=2){
    STEP(pB0,pB1,pA0,pA1,t,true,true,true);     if constexpr(ABL==5){asm volatile("s_waitcnt vmcnt(2) lgkmcnt(0)":::"memory");}else{WAIT_BAR(2);} RESC(); ROT();
    STEP(pA0,pA1,pB0,pB1,t+1,true,true,true);   if constexpr(ABL==5){asm volatile("s_waitcnt vmcnt(2) lgkmcnt(0)":::"memory");}else{WAIT_BAR(2);} RESC(); ROT();
  }
  #undef CMASK
  #define CMASK(P0,P1,t) do{}while(0)
  #define ENDW(tt) do{ if((tt)+3<NT){WAIT_BAR(2);} else if((tt)+2<NT){WAIT_BAR(1);} else {WAIT_BAR(0);} }while(0)
  for(;t+1<NT;t+=2){
    STEP(pB0,pB1,pA0,pA1,t,(t+3<NT),(t+1<NT),(t+1<NT));       ENDW(t);   RESC(); ROT();
    STEP(pA0,pA1,pB0,pB1,t+1,(t+4<NT),(t+2<NT),(t+2<NT));     ENDW(t+1); RESC(); ROT();
  }
  STEP(pB0,pB1,pA0,pA1,NT-1,false,false,false); RESC();
  { float sacc=pB0[0]+pB0[1]; _Pragma("unroll") for(int r=2;r<16;++r)sacc+=pB0[r]; _Pragma("unroll") for(int r=0;r<16;++r)sacc+=pB1[r]; l_reg+=sacc;
    pw0=(u32x4){PKW(pB0,0),PKW(pB0,2),PKW(pB0,4),PKW(pB0,6)};pw1=(u32x4){PKW(pB0,8),PKW(pB0,10),PKW(pB0,12),PKW(pB0,14)};pw2=(u32x4){PKW(pB1,0),PKW(pB1,2),PKW(pB1,4),PKW(pB1,6)};pw3=(u32x4){PKW(pB1,8),PKW(pB1,10),PKW(pB1,12),PKW(pB1,14)};
    SBAR(); pv(o,vb0+sl_cur,PAF(0),PAF(1),PAF(2),PAF(3)); }
  #undef PKW
  #undef PAF
  #undef VFR
  #undef PIN
  #undef MX3
  #undef GAPA
  #undef GAPB
  #undef EX
  #undef VRD
  #undef KRD
  #undef STEP
  #undef ENDW
  {auto rr=__builtin_amdgcn_permlane32_swap(__float_as_uint(l_reg),__float_as_uint(l_reg),false,false);l_reg=__uint_as_float(rr[0])+__uint_as_float(rr[1]);}
  if(hi==0)wsf[32+r32]=l_reg;asm volatile("s_waitcnt lgkmcnt(0)":::"memory");
  float rli[16];
  #pragma unroll
  for(int r=0;r<16;++r)rli[r]=__builtin_amdgcn_rcpf(wsf[32+crow(r,hi)]);
  bf16*Ow=O+(rowbase+q0+wid*QBLK)*OP+h*D;
  { bf16*stg=(bf16*)(shm+LDS_OST)+wid*2048;
    #pragma unroll
    for(int r=0;r<16;++r){const int orow=crow(r,hi);
      #pragma unroll
      for(int d0=0;d0<2;++d0)stg[orow*64+d0*32+r32]=__float2bfloat16(o[d0][r]*rli[r]);}
    asm volatile("s_waitcnt lgkmcnt(0)":::"memory");
    #pragma unroll
    for(int i=0;i<4;++i){const int row=i*8+(lane>>3),ch=lane&7; const u32x4 v=*(const u32x4*)(stg+row*64+ch*8); ATTN_STORE16(Ow+(long)row*OP+ch*8,v);} }
  asm volatile("s_waitcnt lgkmcnt(0)\n\ts_barrier":::"memory");
  #undef DMA_K
  #undef DMA_V
  #undef CMASK
  #undef START
  #undef RESC
  #undef ROT
}

constexpr int A64_K=0, A64_V=65536, A64_WS=98304, LDS_BYTES64=A64_WS+NW*64*4;
typedef int v8i_t __attribute__((ext_vector_type(8)));
__device__ __forceinline__ void attn_unit64f8(int b,int h,int qb,const unsigned char*Q8,const unsigned char*K8,const bf16*__restrict__ V,bf16*O,char*shm){
  int tid_=threadIdx.x; asm volatile("":"+v"(tid_)); const int tid=tid_,lane=tid&63,r32=lane&31,hi=lane>>5; const int wid=__builtin_amdgcn_readfirstlane(tid>>6);
  const long rowbase=(long)b*SEQ; const int q0=qb*(2*QB);
  const unsigned char*Qw8=Q8+(rowbase+q0+wid*64)*512+h*64;
  const unsigned char*Kh8=K8+(long)b*NKEYS*128+(h>>2)*64; const bf16*Vh=V+(long)b*NKEYS*KP+(h>>2)*D;
  const unsigned lds0=(unsigned)(uintptr_t)shm;
  const unsigned char*ksrc=Kh8+(long)lane*128+(wid&3)*16;
  const bf16*vsrc=Vh+(long)(16*(wid&3)+(lane>>2))*KP+(wid>>2)*32+(lane&3)*8;
  const unsigned kdst=lds0+A64_K+(wid&3)*1024, vdst=lds0+A64_V+wid*1024;
  #define DMA_KP(p,slot) glds16((p),(unsigned)__builtin_amdgcn_readfirstlane(kdst+(slot)))
  #define DMA_VP(p,slot) glds16((p),(unsigned)__builtin_amdgcn_readfirstlane(vdst+(slot)))
  const lds_cptr shm3=(lds_cptr)shm; const lds_cptr kp0=shm3+A64_K+(2*hi)*1024+r32*16; const lds_cptr vp0=shm3+A64_V+((lane>>4)&1)*32+(lane&3)*8+(4*hi+((lane&15)>>2))*64;
  constexpr int NT=NKEYS/KVBLK; static_assert(NT>=8,"peeled head and tail");
  constexpr long TSTEP=(long)KVBLK*KP, TSTEP8=(long)KVBLK*128;
  DMA_KP(ksrc,0);DMA_VP(vsrc,0);DMA_KP(ksrc+TSTEP8,SLOTB);
  v8i_t qr0,qr1;
  { const u32x4 a0=*(const u32x4*)(Qw8+(long)r32*512+32*hi), a1=*(const u32x4*)(Qw8+(long)r32*512+32*hi+16), b0=*(const u32x4*)(Qw8+(long)(32+r32)*512+32*hi), b1=*(const u32x4*)(Qw8+(long)(32+r32)*512+32*hi+16);
    qr0=(v8i_t){(int)a0.x,(int)a0.y,(int)a0.z,(int)a0.w,(int)a1.x,(int)a1.y,(int)a1.z,(int)a1.w}; qr1=(v8i_t){(int)b0.x,(int)b0.y,(int)b0.z,(int)b0.w,(int)b1.x,(int)b1.y,(int)b1.z,(int)b1.w}; }
  DMA_KP(ksrc+2*TSTEP8,2*SLOTB);DMA_VP(vsrc+TSTEP,SLOTB);
  const unsigned char*kq=ksrc+3*TSTEP8; const bf16*vq=vsrc+2*TSTEP;
  f32x16 o0[2],o1[2]; o0[0]=f32x16{};o0[1]=f32x16{};o1[0]=f32x16{};o1[1]=f32x16{};
  typedef float f32x4_t __attribute__((ext_vector_type(4))); f32x4_t lacc0={0.f,0.f,0.f,0.f},lacc1={0.f,0.f,0.f,0.f};
  bf16x8 sel; { const short one=((lane&15)==((lane>>4)&1))?(short)0x3F80:(short)0; sel=(bf16x8){one,one,one,one,one,one,one,one}; asm volatile("":"+v"(sel)); }
  v8i_t kfA,kfB; f32x16 S0a,S0b,S1a,S1b;
  #define KR8(dst,kp) do{ const u32x4 x0_=*(const __attribute__((address_space(3))) u32x4*)(kp), x1_=*(const __attribute__((address_space(3))) u32x4*)((kp)+1024); \
    dst=(v8i_t){(int)x0_.x,(int)x0_.y,(int)x0_.z,(int)x0_.w,(int)x1_.x,(int)x1_.y,(int)x1_.z,(int)x1_.w}; }while(0)
  WAIT_BAR(2);
  KR8(kfA,kp0);
  #define MF(a,b,c) __builtin_amdgcn_mfma_f32_32x32x16_bf16(a,b,c,0,0,0)
  #define MF8(a,b) __builtin_amdgcn_mfma_scale_f32_32x32x64_f8f6f4(a,b,ZZ,0,0,0,0,0,0)
  #define MFS(PF,LA) LA=__builtin_amdgcn_mfma_f32_16x16x32_bf16(sel,PF,LA,0,0,0)
  #define PIN(x) asm volatile("":"+v"(x))
  #define E2(X,p) do{ X[2*(p)]=__builtin_amdgcn_exp2f(X[2*(p)]); X[2*(p)+1]=__builtin_amdgcn_exp2f(X[2*(p)+1]); PIN(X); }while(0)
  #define P1(X,p) do{ X[((p)&4)*2+((p)&3)]=__uint_as_float(cvtpk_s(X[2*(p)],X[2*(p)+1])); PIN(X); }while(0)
  #define PLO(X) __builtin_bit_cast(bf16x8,__builtin_shufflevector(X,X,0,1,2,3))
  #define PHI(X) __builtin_bit_cast(bf16x8,__builtin_shufflevector(X,X,8,9,10,11))
  #define VFR(i) (bf16x8){vlo[i][0],vlo[i][1],vlo[i][2],vlo[i][3],vhi[i][0],vhi[i][1],vhi[i][2],vhi[i][3]}
  #define VRDP(vp,i) do{ vlo[i]=vtr((vp)+(((i)>>2)*4096+((i)&3)*1024)); vhi[i]=vtr((vp)+(((i)>>2)*4096+((i)&3)*1024+512)); }while(0)
  #define SLOT(j) ((((j))&3)*SLOTB)
  #define VQ1(g) do{ if((g)==0){E2(S0b,4);P1(S1b,3);} if((g)==1){E2(S1b,4);P1(S0b,4);} if((g)==2){E2(S0b,5);P1(S1b,4);} if((g)==3){E2(S1b,5);P1(S0b,5);} \
                     if((g)==4){E2(S0b,6);P1(S1b,5);} if((g)==5){E2(S1b,6);P1(S0b,6);} if((g)==6){E2(S0b,7);P1(S1b,6);} if((g)==7){E2(S1b,7);P1(S0b,7);} }while(0)
  #define VQ2(g,FIRST) do{ if((g)==0){E2(S0a,0); if(!(FIRST)){P1(S1b,7);} } if((g)==1){E2(S1a,0);P1(S0a,0);} if((g)==2){E2(S0a,1);P1(S1a,0);} if((g)==3){E2(S1a,1);P1(S0a,1);} \
                     if((g)==4){E2(S0a,2);P1(S1a,1);} if((g)==5){E2(S1a,2);P1(S0a,2);} if((g)==6){E2(S0a,3);P1(S1a,2);} if((g)==7){E2(S1a,3);P1(S0a,3);} }while(0)
  #define VQ3(g) do{ if((g)==0){E2(S0a,4);P1(S1a,3);} if((g)==1){E2(S1a,4);P1(S0a,4);} if((g)==2){E2(S0a,5);P1(S1a,4);} if((g)==3){E2(S1a,5);P1(S0a,5);} \
                     if((g)==4){E2(S0a,6);P1(S1a,5);} if((g)==5){E2(S1a,6);P1(S0a,6);} if((g)==6){E2(S0a,7);P1(S1a,6);} if((g)==7){E2(S1a,7);P1(S0a,7);} }while(0)
  #define VQ4(g) do{ if((g)==0){E2(S0b,0);P1(S1a,7);} if((g)==1){E2(S1b,0);P1(S0b,0);} if((g)==2){E2(S0b,1);P1(S1b,0);} if((g)==3){E2(S1b,1);P1(S0b,1);} \
                     if((g)==4){E2(S0b,2);P1(S1b,1);} if((g)==5){E2(S1b,2);P1(S0b,2);} if((g)==6){E2(S0b,3);P1(S1b,2);} if((g)==7){E2(S1b,3);P1(S0b,3);} }while(0)
  #define SL(i,FIRST) do{ if((i)<8){ if(!(FIRST)){VQ1((i)&7);} } else if((i)<16){ VQ2((i)&7,FIRST); } else if((i)<24){ VQ3((i)&7); } else { VQ4((i)&7); } }while(0)
  #define STEPF(s,FIRST,GK,GV,GL) do{ s16x4 vlo[8],vhi[8]; const f32x16 ZZ=f32x16{}; \
    const lds_cptr vpp=vp0+SLOT((s)+3), vpc=vp0+SLOT(s), kpc=kp0+SLOT(s), kpn=kp0+SLOT((s)+1); \
    SBAR(); \
    S0a=MF8(kfA,qr0); SL(0,FIRST); SL(1,FIRST); SL(2,FIRST); if(!(FIRST)){VRDP(vpp,2); VRDP(vpp,6);} KR8(kfB,kpc+512); SBAR(); \
    if(GK){DMA_KP(kq,SLOT((s)+3));} if(GV){DMA_VP(vq,SLOT((s)+2));} kq+=TSTEP8; vq+=TSTEP; SBAR(); \
    S1a=MF8(kfA,qr1); SL(3,FIRST); SL(4,FIRST); SL(5,FIRST); if(!(FIRST)){VRDP(vpp,3); VRDP(vpp,7);} SBAR(); \
    if(!(FIRST)){o0[0]=MF(PLO(S0b),VFR(2),o0[0]); MFS(PLO(S0b),lacc0);} SL(6,FIRST); SL(7,FIRST); SBAR(); \
    if(!(FIRST)){o1[0]=MF(PLO(S1b),VFR(2),o1[0]); MFS(PLO(S1b),lacc1);} SL(8,FIRST); SL(9,FIRST); SBAR(); \
    if(!(FIRST)){o0[1]=MF(PLO(S0b),VFR(6),o0[1]);} SL(10,FIRST); SBAR(); \
    if(!(FIRST)){o1[1]=MF(PLO(S1b),VFR(6),o1[1]);} SL(11,FIRST); SBAR(); \
    if(!(FIRST)){o0[0]=MF(PHI(S0b),VFR(3),o0[0]); MFS(PHI(S0b),lacc0);} SL(12,FIRST); SBAR(); \
    if(!(FIRST)){o1[0]=MF(PHI(S1b),VFR(3),o1[0]); MFS(PHI(S1b),lacc1);} SL(13,FIRST); SBAR(); \
    if(!(FIRST)){o0[1]=MF(PHI(S0b),VFR(7),o0[1]);} SL(14,FIRST); SBAR(); \
    if(!(FIRST)){o1[1]=MF(PHI(S1b),VFR(7),o1[1]);} SL(15,FIRST); SBAR(); \
    S0b=MF8(kfB,qr0); SL(16,FIRST); SL(17,FIRST); SL(18,FIRST); VRDP(vpc,0); VRDP(vpc,4); if(GL){KR8(kfA,kpn);} SBAR(); \
    S1b=MF8(kfB,qr1); SL(19,FIRST); SL(20,FIRST); SL(21,FIRST); VRDP(vpc,1); VRDP(vpc,5); SBAR(); \
    o0[0]=MF(PLO(S0a),VFR(0),o0[0]); MFS(PLO(S0a),lacc0); SL(22,FIRST); SL(23,FIRST); SBAR(); \
    o1[0]=MF(PLO(S1a),VFR(0),o1[0]); MFS(PLO(S1a),lacc1); SL(24,FIRST); SL(25,FIRST); SBAR(); \
    o0[1]=MF(PLO(S0a),VFR(4),o0[1]); SL(26,FIRST); SBAR(); \
    o1[1]=MF(PLO(S1a),VFR(4),o1[1]); SL(27,FIRST); SBAR(); \
    o0[0]=MF(PHI(S0a),VFR(1),o0[0]); MFS(PHI(S0a),lacc0); SL(28,FIRST); SBAR(); \
    o1[0]=MF(PHI(S1a),VFR(1),o1[0]); MFS(PHI(S1a),lacc1); SL(29,FIRST); SBAR(); \
    o0[1]=MF(PHI(S0a),VFR(5),o0[1]); SL(30,FIRST); SBAR(); \
    o1[1]=MF(PHI(S1a),VFR(5),o1[1]); SL(31,FIRST); SBAR(); \
    }while(0)
  STEPF(0,true,true,true,true); WAIT_BAR(2);
  #pragma unroll 1
  for(int s=1;s<NT-3;++s){ STEPF(s,false,true,true,true); WAIT_BAR(2); }
  STEPF(NT-3,false,false,true,true);  WAIT_BAR(1);
  STEPF(NT-2,false,false,false,true); WAIT_BAR(0);
  STEPF(NT-1,false,false,false,false); WAIT_BAR(0);
  {
    s16x4 vlo[8],vhi[8]; const lds_cptr vpp=vp0+SLOT(NT-1);
    SBAR(); VRDP(vpp,2); VRDP(vpp,6); VRDP(vpp,3); VRDP(vpp,7); SBAR();
    VQ1(0);VQ1(1);VQ1(2);VQ1(3);VQ1(4);VQ1(5);VQ1(6);VQ1(7); P1(S1b,7); SBAR();
    o0[0]=MF(PLO(S0b),VFR(2),o0[0]); MFS(PLO(S0b),lacc0); o1[0]=MF(PLO(S1b),VFR(2),o1[0]); MFS(PLO(S1b),lacc1);
    o0[1]=MF(PLO(S0b),VFR(6),o0[1]); o1[1]=MF(PLO(S1b),VFR(6),o1[1]);
    o0[0]=MF(PHI(S0b),VFR(3),o0[0]); MFS(PHI(S0b),lacc0); o1[0]=MF(PHI(S1b),VFR(3),o1[0]); MFS(PHI(S1b),lacc1);
    o0[1]=MF(PHI(S0b),VFR(7),o0[1]); o1[1]=MF(PHI(S1b),VFR(7),o1[1]); SBAR(); }
  #undef MF
  #undef MF8
  #undef MFS
  #undef PIN
  #undef E2
  #undef P1
  #undef PLO
  #undef PHI
  #undef VFR
  #undef VRDP
  #undef KR8
  #undef SLOT
  #undef VQ1
  #undef VQ2
  #undef VQ3
  #undef VQ4
  #undef SL
  #undef STEPF
  #undef DMA_KP
  #undef DMA_VP
  asm volatile("s_waitcnt lgkmcnt(0)\n\ts_barrier":::"memory");
  { int le=lane; asm volatile("":"+v"(le)); const int r32e=le&31,hie=le>>5;
    float*wse=(float*)(shm+A64_WS)+wid*64;
    if(le<16){wse[le]=lacc0[0];wse[16+le]=lacc0[1];wse[32+le]=lacc1[0];wse[48+le]=lacc1[1];} asm volatile("s_waitcnt lgkmcnt(0)":::"memory");
    bf16*Ow=O+(rowbase+q0+wid*64)*OP+h*D;
    bf16*stg=(bf16*)(shm)+wid*4096;
    #pragma unroll
    for(int r=0;r<16;++r){const int orow=crow(r,hie); const float rl=__builtin_amdgcn_rcpf(wse[orow]);
      #pragma unroll
      for(int d0=0;d0<2;++d0)stg[orow*64+d0*32+r32e]=__float2bfloat16(o0[d0][r]*rl);}
    #pragma unroll
    for(int r=0;r<16;++r){const int orow=crow(r,hie); const float rl=__builtin_amdgcn_rcpf(wse[32+orow]);
      #pragma unroll
      for(int d0=0;d0<2;++d0)stg[(32+orow)*64+d0*32+r32e]=__float2bfloat16(o1[d0][r]*rl);}
    asm volatile("s_waitcnt lgkmcnt(0)":::"memory");
    #pragma unroll
    for(int i=0;i<8;++i){const int row=i*8+(le>>3),ch=le&7; const u32x4 v=*(const u32x4*)(stg+row*64+ch*8); ATTN_STORE16(Ow+(long)row*OP+ch*8,v);} }
  asm volatile("s_waitcnt lgkmcnt(0)\n\ts_barrier":::"memory");
}

__device__ __forceinline__ void attn_unit64ff(int b,int h,int qb,const unsigned char*Q8,const unsigned char*K8,const unsigned char*V8T,bf16*O,char*shm){
  int tid_=threadIdx.x; asm volatile("":"+v"(tid_)); const int tid=tid_,lane=tid&63,r32=lane&31,hi=lane>>5; const int wid=__builtin_amdgcn_readfirstlane(tid>>6);
  const long rowbase=(long)b*SEQ; const int q0=qb*(2*QB);
  const unsigned char*Qw8=Q8+(rowbase+q0+wid*64)*512+h*64;
  const unsigned char*Kh8=K8+(long)b*NKEYS*128+(h>>2)*64; const unsigned char*Vt8=V8T+(long)((b*2+(h>>2))*(NKEYS/KVBLK))*4096;
  const unsigned lds0=(unsigned)(uintptr_t)shm;
  const bool kw=wid<4; const int ch=wid&3;
  const unsigned char*dsrc=kw?Kh8+(long)lane*128+ch*16:Vt8+(long)lane*64+ch*16;
  const long dstep=kw?(long)KVBLK*128:4096;
  const unsigned ddst=lds0+(kw?A64_K:A64_V)+ch*1024;
  #define DMA1(p,slot) glds16((p),(unsigned)__builtin_amdgcn_readfirstlane(ddst+(slot)))
  const lds_cptr shm3=(lds_cptr)shm; const lds_cptr kp0=shm3+A64_K+(2*hi)*1024+r32*16; const lds_cptr vfp0=shm3+A64_V+(2*hi)*1024+r32*16;
  constexpr int NT=NKEYS/KVBLK; static_assert((NT-3)%3==0&&NT>=6,"steady loop runs three steps (one ring turn) per iteration, then three peeled steps");
  DMA1(dsrc,0); if(kw){DMA1(dsrc+dstep,SLOTB);}
  v8i_t qr0,qr1;
  { const u32x4 a0=*(const u32x4*)(Qw8+(long)r32*512+32*hi), a1=*(const u32x4*)(Qw8+(long)r32*512+32*hi+16), b0=*(const u32x4*)(Qw8+(long)(32+r32)*512+32*hi), b1=*(const u32x4*)(Qw8+(long)(32+r32)*512+32*hi+16);
    qr0=(v8i_t){(int)a0.x,(int)a0.y,(int)a0.z,(int)a0.w,(int)a1.x,(int)a1.y,(int)a1.z,(int)a1.w}; qr1=(v8i_t){(int)b0.x,(int)b0.y,(int)b0.z,(int)b0.w,(int)b1.x,(int)b1.y,(int)b1.z,(int)b1.w}; }
  if(kw){DMA1(dsrc+2*dstep,2*SLOTB);}else{DMA1(dsrc+dstep,SLOTB);}
  const unsigned char*dq=dsrc+(kw?3*dstep:2*dstep);
  f32x16 o0[2],o1[2]; o0[0]=f32x16{};o0[1]=f32x16{};o1[0]=f32x16{};o1[1]=f32x16{};
  typedef float f32x4_t __attribute__((ext_vector_type(4))); f32x4_t lacc0={0.f,0.f,0.f,0.f},lacc1={0.f,0.f,0.f,0.f};
  v8i_t sel8; { const int one=((lane&15)==((lane>>4)&1))?0x38383838:0; sel8=(v8i_t){one,one,one,one,one,one,one,one}; asm volatile("":"+v"(sel8)); }
  v8i_t kfA,kfB;
  #define KR8(dst,kp) do{ const u32x4 x0_=*(const __attribute__((address_space(3))) u32x4*)(kp), x1_=*(const __attribute__((address_space(3))) u32x4*)((kp)+1024); \
    dst=(v8i_t){(int)x0_.x,(int)x0_.y,(int)x0_.z,(int)x0_.w,(int)x1_.x,(int)x1_.y,(int)x1_.z,(int)x1_.w}; }while(0)
  WAIT_BAR(1);
  KR8(kfA,kp0); KR8(kfB,kp0+512);
  WAIT_BAR(1);
  #define MF8(a,b) __builtin_amdgcn_mfma_scale_f32_32x32x64_f8f6f4(a,b,ZZ,0,0,0,0,0,0)
  #define MF8P(pa,vb,c) __builtin_amdgcn_mfma_scale_f32_32x32x64_f8f6f4(pa,vb,c,1,0,0,0,0,0)
  #define MFSF(pa,LA) LA=__builtin_amdgcn_mfma_scale_f32_16x16x128_f8f6f4(sel8,pa,LA,0,1,0,0,0,0)
  #define PIN(x) asm volatile("":"+v"(x))
  #define E2(X,p) do{ X[2*(p)]=__builtin_amdgcn_exp2f(X[2*(p)]); X[2*(p)+1]=__builtin_amdgcn_exp2f(X[2*(p)+1]); }while(0)
  #define K2(X,p,T,WB) do{ T[(WB)+((p)>>1)]=__builtin_bit_cast(float,__builtin_amdgcn_cvt_pk_bf8_f32(X[2*(p)],X[2*(p)+1],__float_as_int(T[(WB)+((p)>>1)]),((p)&1)!=0)); }while(0)
  #define SL8(X,T,WB) do{ E2(X,0); E2(X,1); K2(X,0,T,WB); E2(X,2); K2(X,1,T,WB); E2(X,3); K2(X,2,T,WB); E2(X,4); K2(X,3,T,WB); E2(X,5); K2(X,4,T,WB); E2(X,6); K2(X,5,T,WB); E2(X,7); K2(X,6,T,WB); }while(0)
  #define P8(X) __builtin_bit_cast(v8i_t,__builtin_shufflevector(X,X,0,1,2,3,4,5,6,7))
  #define SL4A(X,T,WB) do{ E2(X,0); E2(X,1); K2(X,0,T,WB); E2(X,2); K2(X,1,T,WB); E2(X,3); K2(X,2,T,WB); PIN(X); PIN(T); }while(0)
  #define SL4B(X,T,WB) do{ E2(X,4); K2(X,3,T,WB); E2(X,5); K2(X,4,T,WB); E2(X,6); K2(X,5,T,WB); E2(X,7); K2(X,6,T,WB); PIN(X); PIN(T); }while(0)
  #define STEPX(C0a,C0b,C1a,C1b,N0a,N0b,N1a,N1b,FIRST,GD,LAST) do{ const f32x16 ZZ=f32x16{}; \
    SBAR(); \
    if(!(FIRST)){o0[0]=MF8P(P8(N0a),vf0,o0[0]); MFSF(P8(N0a),lacc0);} SL4A(C0a,C0a,0); SBAR(); \
    if(GD){ DMA1(dq,kw?sc:sp); } dq+=dstep; SBAR(); \
    if(!(FIRST)){o0[1]=MF8P(P8(N0a),vf1,o0[1]);} SL4B(C0a,C0a,0); if(!(LAST)){KR8(kfA,kp0+sn);} SBAR(); \
    if(!(FIRST)){o1[0]=MF8P(P8(N1a),vf0,o1[0]); MFSF(P8(N1a),lacc1);} K2(C0a,7,C0a,0); SL4A(C0b,C0a,4); if(!(LAST)){KR8(kfB,kp0+sn+512);} SBAR(); \
    if(!(FIRST)){o1[1]=MF8P(P8(N1a),vf1,o1[1]);} SL4B(C0b,C0a,4); SBAR(); \
    if(!(LAST)){N0a=MF8(kfA,qr0);} K2(C0b,7,C0a,4); SL4A(C1a,C1a,0); SBAR(); \
    if(!(LAST)){N0b=MF8(kfB,qr0);} SL4B(C1a,C1a,0); KR8(vf0,vfp0+sc); SBAR(); \
    if(!(LAST)){N1a=MF8(kfA,qr1);} K2(C1a,7,C1a,0); SL4A(C1b,C1a,4); KR8(vf1,vfp0+sc+512); SBAR(); \
    if(!(LAST)){N1b=MF8(kfB,qr1);} SL4B(C1b,C1a,4); K2(C1b,7,C1a,4); SBAR(); \
    { const int t_=sc; sc=sn; sn=sp; sp=t_; } \
    }while(0)
  f32x16 A0a,A0b,A1a,A1b,B0a,B0b,B1a,B1b; v8i_t vf0,vf1; int sc=0,sn=SLOTB,sp=2*SLOTB;
  { const f32x16 ZZ=f32x16{}; A0a=MF8(kfA,qr0); A0b=MF8(kfB,qr0); A1a=MF8(kfA,qr1); A1b=MF8(kfB,qr1); }
  STEPX(A0a,A0b,A1a,A1b,B0a,B0b,B1a,B1b,true,true,false);  WAIT_BAR(1);
  STEPX(B0a,B0b,B1a,B1b,A0a,A0b,A1a,A1b,false,true,false); WAIT_BAR(1);
  #pragma unroll 1
  for(int t=2;t<NT-4;t+=2){
    STEPX(A0a,A0b,A1a,A1b,B0a,B0b,B1a,B1b,false,true,false); WAIT_BAR(1);
    STEPX(B0a,B0b,B1a,B1b,A0a,A0b,A1a,A1b,false,true,false); WAIT_BAR(1);
  }
  STEPX(A0a,A0b,A1a,A1b,B0a,B0b,B1a,B1b,false,true,false);   WAIT_BAR(1);
  STEPX(B0a,B0b,B1a,B1b,A0a,A0b,A1a,A1b,false,(!kw),false);  WAIT_BAR(0);
  STEPX(A0a,A0b,A1a,A1b,B0a,B0b,B1a,B1b,false,false,false);  WAIT_BAR(0);
  STEPX(B0a,B0b,B1a,B1b,A0a,A0b,A1a,A1b,false,false,true);
  o0[0]=MF8P(P8(B0a),vf0,o0[0]); MFSF(P8(B0a),lacc0); o0[1]=MF8P(P8(B0a),vf1,o0[1]);
  o1[0]=MF8P(P8(B1a),vf0,o1[0]); MFSF(P8(B1a),lacc1); o1[1]=MF8P(P8(B1a),vf1,o1[1]);
  #undef SL4A
  #undef SL4B
  #undef STEPX
  #undef MF8
  #undef MF8P
  #undef MFSF
  #undef PIN
  #undef E2
  #undef K2
  #undef SL8
  #undef P8
  #undef KR8
  #undef DMA1
  asm volatile("s_waitcnt lgkmcnt(0)\n\ts_barrier":::"memory");
  { int le=lane; asm volatile("":"+v"(le)); const int r32e=le&31,hie=le>>5;
    float*wse=(float*)(shm+A64_WS)+wid*64;
    if(le<16){wse[le]=lacc0[0];wse[16+le]=lacc0[1];wse[32+le]=lacc1[0];wse[48+le]=lacc1[1];} asm volatile("s_waitcnt lgkmcnt(0)":::"memory");
    bf16*Ow=O+(rowbase+q0+wid*64)*OP+h*D;
    bf16*stg=(bf16*)(shm)+wid*4096;
    #pragma unroll
    for(int r=0;r<16;++r){const int orow=crow(r,hie); const float rl=__builtin_amdgcn_rcpf(wse[orow]);
      #pragma unroll
      for(int d0=0;d0<2;++d0)stg[orow*64+d0*32+r32e]=__float2bfloat16(o0[d0][r]*rl);}
    #pragma unroll
    for(int r=0;r<16;++r){const int orow=crow(r,hie); const float rl=__builtin_amdgcn_rcpf(wse[32+orow]);
      #pragma unroll
      for(int d0=0;d0<2;++d0)stg[(32+orow)*64+d0*32+r32e]=__float2bfloat16(o1[d0][r]*rl);}
    asm volatile("s_waitcnt lgkmcnt(0)":::"memory");
    #pragma unroll
    for(int i=0;i<8;++i){const int row=i*8+(le>>3),ch2=le&7; const u32x4 v=*(const u32x4*)(stg+row*64+ch2*8); ATTN_STORE16(Ow+(long)row*OP+ch2*8,v);} }
  asm volatile("s_waitcnt lgkmcnt(0)\n\ts_barrier":::"memory");
}
constexpr int ATTN_LDS_BYTES=LDS_BYTES;
struct AttnTensors { const bf16* Q; const bf16* K; const bf16* V; bf16* O; const unsigned char* Q8; const unsigned char* K8; const unsigned char* V8T; };
struct AttnUnit { int b; int h; int qb; };
struct StaticOrder {
  int vcu, G;
  __device__ __forceinline__ StaticOrder(int v,int g):vcu(v),G(g){}
  __device__ __forceinline__ bool next(int i,AttnUnit&u)const{
    int id; if(G==256){ if(i>=4)return false; id=(vcu>>5)*128+(vcu&31)*4+i; } else { id=i*G+vcu; if(id>=1024)return false; }
    const int x=id>>7, un=id&127; u.b=x>>1; u.h=(x&1)*4+(un>>5); u.qb=un&31; return true; }
  __device__ __forceinline__ bool next64(int i,AttnUnit&u)const{
    int id; if(G==256){ if(i>=2)return false; id=(vcu>>5)*64+(vcu&31)*2+i; } else { id=i*G+vcu; if(id>=512)return false; }
    const int x=id>>6, un=id&63; u.b=x>>1; u.h=(x&1)*4+(un>>4); u.qb=un&15; return true; }
};
template<class Sched,int THRL=8> __device__ __forceinline__ void attn_phase(char*lds,const AttnTensors&T,const Sched&S,bool noref,bool pv8){
  AttnUnit u;
  if(noref&&pv8){ for(int i=0;S.next64(i,u);++i){ attn_unit64ff(u.b,u.h,u.qb,T.Q8,T.K8,T.V8T,T.O,lds); } }
  else if(noref){ for(int i=0;S.next64(i,u);++i){ attn_unit64f8(u.b,u.h,u.qb,T.Q8,T.K8,T.V,T.O,lds); } }
  else     { for(int i=0;S.next(i,u);++i){ attn_unit<THRL,false>(u.b,u.h,u.qb,T.Q,T.K,T.V,T.O,lds); } }
}
#undef SBAR
#undef WAIT_BAR
}

constexpr int NWAVES = 8;
constexpr int NPHASE = 8;
constexpr size_t CTL_ZERO_BYTES = 64 * 1024;
constexpr int CW_BAR = 1024;
constexpr int RING_OFF = 0, RING_BYTES = 131072;
constexpr int LDSCTL_OFF = RING_BYTES, MISC_OFF = LDSCTL_OFF + 320;
constexpr int LDS_BYTES = 147456;

#define GAS __attribute__((address_space(1)))
#define LAS __attribute__((address_space(3)))
typedef unsigned v4u __attribute__((ext_vector_type(4)));
typedef unsigned v2u __attribute__((ext_vector_type(2)));
typedef float f32x4 __attribute__((ext_vector_type(4)));
typedef short bf16x8 __attribute__((ext_vector_type(8)));
#define LDS_WAIT() asm volatile("s_waitcnt lgkmcnt(0)" ::: "memory")
#define VM_WAIT() asm volatile("s_waitcnt vmcnt(0)" ::: "memory")
__device__ __forceinline__ unsigned pk2(float lo, float hi) { return (unsigned)f2bf(lo) | ((unsigned)f2bf(hi) << 16); }
__device__ __forceinline__ unsigned pk4_f8(float a, float b, float c, float d) { int w = __builtin_amdgcn_cvt_pk_fp8_f32(a, b, 0, false); w = __builtin_amdgcn_cvt_pk_fp8_f32(c, d, w, true); return (unsigned)w; }

#define XB_TMO      128
#define XB_XCNT(j)  (256  + 64 * (j))
#define XB_XSUB(j)  (1280 + 64 * (j))
#define XB_XGEN(j)  (2304 + 64 * (j))
#define XB_TOP      3328
#define XB_TOPGEN   3392
#define XCD_BAR_WORDS 3456
#define XB_SPIN_CAP (1u << 18)
__device__ __forceinline__ unsigned xb_ld(unsigned* p)              { return __hip_atomic_load(p, __ATOMIC_RELAXED, __HIP_MEMORY_SCOPE_AGENT); }
__device__ __forceinline__ unsigned xb_add(unsigned* p, unsigned v) { return __hip_atomic_fetch_add(p, v, __ATOMIC_RELAXED, __HIP_MEMORY_SCOPE_AGENT); }
__device__ __forceinline__ unsigned xb_xcc_id() { return (unsigned)__builtin_amdgcn_s_getreg((3 << 11) | 20) & 0xFu; }
#define XB_SPIN(cond, bar) do { unsigned _sp = 0; while (cond) { __builtin_amdgcn_s_sleep(1); \
    if ((++_sp & 255u) == 0u) { if (xb_ld(&(bar)[XB_TMO])) break; if (_sp > XB_SPIN_CAP) { atomicAdd(&(bar)[XB_TMO], 1u); break; } } } } while (0)
struct XcdBarrier { unsigned* bar; unsigned x; volatile LAS unsigned* st; };
__device__ __forceinline__ XcdBarrier xcd_barrier_post(unsigned* bar, volatile LAS unsigned* st) {
    XcdBarrier b; b.bar = bar; b.x = xb_xcc_id(); b.st = st;
    if (threadIdx.x == 0) (void)xb_add(&bar[XB_XCNT(b.x)], 1u);
    return b;
}
__device__ __forceinline__ void xcd_barrier_complete(unsigned* bar, unsigned x, unsigned& nloc, unsigned& nx) {
    const unsigned G = gridDim.x * gridDim.y * gridDim.z;
    unsigned sum, cnt, mine, sp = 0u;
    for (;;) {
        sum = 0u; cnt = 0u; mine = 0u;
#pragma unroll
        for (unsigned j = 0; j < 16; ++j) { const unsigned c = xb_ld(&bar[XB_XCNT(j)]); sum += c; cnt += (c > 0u) ? 1u : 0u; mine = (j == x) ? c : mine; }
        if (sum == G) break;
        __builtin_amdgcn_s_sleep(1);
        if ((++sp & 255u) == 0u) { if (xb_ld(&bar[XB_TMO])) break; if (sp > XB_SPIN_CAP) { atomicAdd(&bar[XB_TMO], 1u); break; } }
    }
    nloc = mine > 0u ? mine : 1u; nx = cnt > 0u ? cnt : 1u;
}
__device__ __forceinline__ void xcd_barrier(const XcdBarrier& b) {
    asm volatile("s_waitcnt vmcnt(0)" ::: "memory");
    __syncthreads();
    if (threadIdx.x == 0) {
        unsigned* bar = b.bar;
        __builtin_amdgcn_s_waitcnt(0);
        unsigned nloc = b.st[0], nx = b.st[1];
        if (nloc == 0u) { xcd_barrier_complete(bar, b.x, nloc, nx); b.st[0] = nloc; b.st[1] = nx; }
        const unsigned old = xb_add(&bar[XB_XSUB(b.x)], 1u);
        const unsigned gen = old / nloc;
        if (old + 1u == (gen + 1u) * nloc) {
            __builtin_amdgcn_fence(__ATOMIC_RELEASE, "agent");
            asm volatile("s_waitcnt vmcnt(0)" ::: "memory");
            const unsigned og = xb_add(&bar[XB_TOP], 1u);
            const unsigned tg = og / nx;
            if (og + 1u == (tg + 1u) * nx) xb_add(&bar[XB_TOPGEN], 1u);
            else XB_SPIN(xb_ld(&bar[XB_TOPGEN]) == tg, bar);
            __builtin_amdgcn_fence(__ATOMIC_ACQUIRE, "agent");
            asm volatile("s_waitcnt vmcnt(0)" ::: "memory");
        } else {
            XB_SPIN(xb_ld(&bar[XB_TOPGEN]) == gen, bar);
            __builtin_amdgcn_fence(__ATOMIC_ACQUIRE, "agent");
            asm volatile("s_waitcnt vmcnt(0)" ::: "memory");
        }
    }
    __syncthreads();
}

template <int NV, bool SILU>
__device__ __forceinline__ void gemv32(const float* v0, const float* v1, const float* v2, const float* v3, const float* v4, const float* W, int ldw, int col0, const float* bias, float* out, int ostride,
                                       LAS float* scr, int wave, int lane) {
    const float* vp[5] = {v0, v1, v2, v3, v4};
    const int cq = lane & 7, rs = lane >> 3;
    float acc[NV][4];
#pragma unroll
    for (int v = 0; v < NV; ++v)
#pragma unroll
        for (int e = 0; e < 4; ++e) acc[v][e] = 0.f;
#pragma unroll 4
    for (int i = 0; i < 16; ++i) { const int k = wave * 128 + i * 8 + rs; const f32x4 w = *(const f32x4*)(W + (size_t)k * ldw + col0 + 4 * cq);
#pragma unroll
        for (int v = 0; v < NV; ++v) { float a = vp[v][k]; if (SILU) a = siluf_(a);
#pragma unroll
            for (int e = 0; e < 4; ++e) acc[v][e] = fmaf(a, w[e], acc[v][e]); } }
#pragma unroll
    for (int v = 0; v < NV; ++v)
#pragma unroll
        for (int e = 0; e < 4; ++e) { float s = acc[v][e]; s += __shfl_xor(s, 8); s += __shfl_xor(s, 16); s += __shfl_xor(s, 32); acc[v][e] = s; }
    if (lane < 8) {
#pragma unroll
        for (int v = 0; v < NV; ++v)
#pragma unroll
            for (int e = 0; e < 4; ++e) scr[(wave * NV + v) * 32 + 4 * cq + e] = acc[v][e]; }
    __syncthreads();
    const int tid = wave * 64 + lane;
    if (tid < NV * 32) { const int v = tid >> 5, j = tid & 31; float s = 0.f;
#pragma unroll
        for (int w = 0; w < 8; ++w) s += scr[(w * NV + v) * 32 + j];
        if (bias) s += bias[col0 + j];
        out[(size_t)v * ostride + col0 + j] = s; }
    __syncthreads();
}
__device__ __forceinline__ void transpose_item(const float* W, int N, int k0, int n0, bf16_t* WT, int ldt, int drow0, int dk0, LAS float* scr, int lane, unsigned char* WT8 = nullptr) {
#pragma unroll 8
    for (int i = 0; i < 32; ++i) { const int kk = 2 * i + (lane >> 5); scr[kk * 33 + (lane & 31)] = W[(size_t)(k0 + kk) * N + n0 + (lane & 31)]; }
    LDS_WAIT(); asm volatile("" ::: "memory");
    const int c = lane & 7;
#pragma unroll
    for (int j = 0; j < 4; ++j) { const int n = (lane >> 3) + 8 * j; const LAS float* s = scr + (8 * c) * 33 + n;
        v4u o; o.x = pk2(s[0 * 33], s[1 * 33]); o.y = pk2(s[2 * 33], s[3 * 33]); o.z = pk2(s[4 * 33], s[5 * 33]); o.w = pk2(s[6 * 33], s[7 * 33]);
        *(GAS v4u*)(WT + (size_t)(drow0 + n) * ldt + dk0 + 8 * c) = o;
        if (WT8) { v2u o8; o8.x = pk4_f8(s[0 * 33], s[1 * 33], s[2 * 33], s[3 * 33]); o8.y = pk4_f8(s[4 * 33], s[5 * 33], s[6 * 33], s[7 * 33]); *(GAS v2u*)(WT8 + (size_t)(drow0 + n) * ldt + dk0 + 8 * c) = o8; } }
    LDS_WAIT(); asm volatile("" ::: "memory");
}
__device__ __forceinline__ void transpose_item_w1(const float* W, int k0, int n0, bf16_t* W1s, const float* n2g, const float* mod, LAS float* scr, int lane) {
#pragma unroll 8
    for (int i = 0; i < 32; ++i) { const int kk = 2 * i + (lane >> 5); scr[kk * 33 + (lane & 31)] = W[(size_t)(k0 + kk) * D_FF + n0 + (lane & 31)]; }
    LDS_WAIT(); asm volatile("" ::: "memory");
    const int c = lane & 7, kb = k0 + 8 * c;
    const f32x4 ga = *(const f32x4*)(n2g + kb), gb = *(const f32x4*)(n2g + kb + 4);
    float gs[BATCH][8];
#pragma unroll
    for (int b = 0; b < BATCH; ++b) { const float* sc = mod + (size_t)b * NMOD + 4 * DM + kb; const f32x4 sa = *(const f32x4*)sc, sb = *(const f32x4*)(sc + 4);
        gs[b][0] = ga.x * (1.f + sa.x); gs[b][1] = ga.y * (1.f + sa.y); gs[b][2] = ga.z * (1.f + sa.z); gs[b][3] = ga.w * (1.f + sa.w);
        gs[b][4] = gb.x * (1.f + sb.x); gs[b][5] = gb.y * (1.f + sb.y); gs[b][6] = gb.z * (1.f + sb.z); gs[b][7] = gb.w * (1.f + sb.w); }
#pragma unroll
    for (int j = 0; j < 4; ++j) { const int n = (lane >> 3) + 8 * j; const LAS float* s = scr + (8 * c) * 33 + n;
        const float w0 = s[0 * 33], w1 = s[1 * 33], w2 = s[2 * 33], w3 = s[3 * 33], w4 = s[4 * 33], w5 = s[5 * 33], w6 = s[6 * 33], w7 = s[7 * 33];
#pragma unroll
        for (int b = 0; b < BATCH; ++b) { v4u o; o.x = pk2(w0 * gs[b][0], w1 * gs[b][1]); o.y = pk2(w2 * gs[b][2], w3 * gs[b][3]); o.z = pk2(w4 * gs[b][4], w5 * gs[b][5]); o.w = pk2(w6 * gs[b][6], w7 * gs[b][7]);
            *(GAS v4u*)(W1s + (size_t)b * D_FF * DM + (size_t)(n0 + n) * DM + kb) = o; } }
    LDS_WAIT(); asm volatile("" ::: "memory");
}
__device__ __forceinline__ void norm_mod_row(const float* xrow, const float* g, const float* shift, const float* scale, bf16_t* orow, unsigned char* orow8, int lane) {
    const GAS f32x4* xr = (const GAS f32x4*)xrow + lane;
    f32x4 v[4]; float s = 0.f;
#pragma unroll
    for (int j = 0; j < 4; ++j) { v[j] = xr[64 * j]; s += (v[j].x * v[j].x + v[j].y * v[j].y) + (v[j].z * v[j].z + v[j].w * v[j].w); }
    const float rstd = rsqrtf(wave_sum(s) * (1.f / DM) + EPS);
    GAS v2u* o8 = (GAS v2u*)orow + lane;
    GAS unsigned* o4 = (GAS unsigned*)orow8 + lane;
#pragma unroll
    for (int j = 0; j < 4; ++j) { const f32x4 gg = *((const f32x4*)g + lane + 64 * j), sc = *((const f32x4*)scale + lane + 64 * j), sh = *((const f32x4*)shift + lane + 64 * j);
        const f32x4 y = v[j] * rstd * gg * (sc + 1.0f) + sh; v2u w; w.x = pk2(y.x, y.y); w.y = pk2(y.z, y.w); o8[64 * j] = w; o4[64 * j] = pk4_f8(y.x, y.y, y.z, y.w); }
}

__device__ __forceinline__ void gmlp_unit(int chunk, int g, const bf16_t* U, const bf16_t* VGn, const bf16_t* Wsb, const float* bs, bf16_t* AG, LAS unsigned char* scr, int lane) {
    const bf16_t* src = VGn + (size_t)(chunk * 128) * 512 + g * 64;
    {
        v4u tv[16];
#pragma unroll
        for (int it = 0; it < 16; ++it) { const int piece = it * 64 + lane, q = piece >> 3, c0 = (piece & 7) * 8; tv[it] = *(const v4u*)(src + (size_t)q * 512 + c0); }
        const int c0 = (lane & 7) * 8, L8 = (lane & 1) << 3;
        LAS unsigned char* bp = scr + c0 * 256 + (lane >> 3) * 2 + (L8 << 4);
        LAS unsigned char* bm = scr + c0 * 256 + (lane >> 3) * 2 - (L8 << 4);
#pragma unroll
        for (int it = 0; it < 16; ++it) { const v4u v = tv[it];
#pragma unroll
            for (int e = 0; e < 8; ++e) { const int A = it ^ e; const unsigned short val = (unsigned short)((e & 1) ? (v[e >> 1] >> 16) : (v[e >> 1] & 0xffffu));
                *(LAS unsigned short*)(((A & 8) ? bm : bp) + e * 256 + (A << 4)) = val; } }
    }
    LDS_WAIT(); asm volatile("" ::: "memory");
    const int fr = lane & 15, fq = lane >> 4;
#pragma unroll 1
    for (int ph = 0; ph < 2; ++ph) {
        bf16x8 Yf[2][4]; v2u uu[4][4]; float bias[4];
#pragma unroll
        for (int pt = 0; pt < 4; ++pt) Yf[0][pt] = *(const bf16x8*)(Wsb + ((size_t)g * 128 + 64 * ph + 16 * pt + fr) * 128 + 8 * fq);
#pragma unroll
        for (int pt = 0; pt < 4; ++pt) { const int p = 64 * ph + 16 * pt + fr; const size_t row = (size_t)chunk * 128 + p; bias[pt] = bs[g * 128 + p];
#pragma unroll
            for (int ct = 0; ct < 4; ++ct) uu[pt][ct] = *(const v2u*)(U + row * 512 + g * 64 + 16 * ct + 4 * fq); }
        f32x4 acc[4][4];
#pragma unroll
        for (int ct = 0; ct < 4; ++ct)
#pragma unroll
            for (int pt = 0; pt < 4; ++pt) acc[ct][pt] = (f32x4){0.f, 0.f, 0.f, 0.f};
#pragma unroll
        for (int ks = 0; ks < 4; ++ks) {
            bf16x8 X[4];
            if (ks < 3) {
#pragma unroll
                for (int pt = 0; pt < 4; ++pt) Yf[(ks + 1) & 1][pt] = *(const bf16x8*)(Wsb + ((size_t)g * 128 + 64 * ph + 16 * pt + fr) * 128 + 32 * (ks + 1) + 8 * fq); }
#pragma unroll
            for (int ct = 0; ct < 4; ++ct) { const int c = 16 * ct + fr; X[ct] = *(const LAS bf16x8*)(scr + c * 256 + (((4 * ks + fq) ^ (c & 15)) << 4)); }
#pragma unroll
            for (int ct = 0; ct < 4; ++ct)
#pragma unroll
                for (int pt = 0; pt < 4; ++pt) acc[ct][pt] = __builtin_amdgcn_mfma_f32_16x16x32_bf16(X[ct], Yf[ks & 1][pt], acc[ct][pt], 0, 0, 0);
        }
#pragma unroll
        for (int pt = 0; pt < 4; ++pt) { const int p = 64 * ph + 16 * pt + fr; const size_t row = (size_t)chunk * 128 + p;
#pragma unroll
            for (int ct = 0; ct < 4; ++ct) { const int c = 16 * ct + 4 * fq; const f32x4 a = acc[ct][pt]; const v2u u2 = uu[pt][ct];
                v2u w; w.x = pk2((a[0] + bias[pt]) * __uint_as_float(u2.x << 16), (a[1] + bias[pt]) * __uint_as_float(u2.x & 0xffff0000u));
                w.y = pk2((a[2] + bias[pt]) * __uint_as_float(u2.y << 16), (a[3] + bias[pt]) * __uint_as_float(u2.y & 0xffff0000u));
                *(v2u*)(AG + row * 1024 + 512 + g * 64 + c) = w; } }
    }
    LDS_WAIT(); asm volatile("" ::: "memory");
}

struct Args { const float* in[19]; float* out; unsigned char* ws; int ph_lo, ph_hi; };
__global__ void __launch_bounds__(NWAVES * 64, 2) mega_fwd(Args args) {
    extern __shared__ __attribute__((aligned(16))) unsigned char lds[];
    LAS unsigned char* L = (LAS unsigned char*)lds;
    volatile LAS unsigned* MISC = (volatile LAS unsigned*)(L + MISC_OFF);
    const int tid = threadIdx.x, lane = tid & 63, wave = __builtin_amdgcn_readfirstlane(tid >> 6);
    const int G = gridDim.x, bx = blockIdx.x, vcu = (G % 8 == 0) ? (bx % 8) * (G / 8) + bx / 8 : bx;
    unsigned char* ws = args.ws;
    const float* x = args.in[0]; const float* c = args.in[1]; const float* ctx = args.in[2]; const float* c_ctx = args.in[3];
    const float* w_mod = args.in[4]; const float* b_mod = args.in[5]; const float* norm1_g = args.in[6]; const float* norm2_g = args.in[7];
    const float* w_in = args.in[8]; const float* q_norm_g = args.in[9]; const float* k_norm_g = args.in[10]; const float* gm_norm_g = args.in[11];
    const float* gm_ws = args.in[12]; const float* gm_bs = args.in[13]; const float* w_br_attn = args.in[14]; const float* w_br_gm = args.in[15];
    const float* w_out = args.in[16]; const float* w_ff1 = args.in[17]; const float* w_ff2 = args.in[18];
    float* out = args.out;
    float* mod = (float*)(ws + WS_MOD); float* cvec = (float*)(ws + WS_CVEC); float* rope = (float*)(ws + WS_ROPE); float* ssq = (float*)(ws + WS_SSQ);
    bf16_t* Win_t = (bf16_t*)(ws + WS_WIN); bf16_t* Wm_t = (bf16_t*)(ws + WS_WM); bf16_t* Wout_t = (bf16_t*)(ws + WS_WOUT); bf16_t* W1_t = (bf16_t*)(ws + WS_W1); bf16_t* W2_t = (bf16_t*)(ws + WS_W2); bf16_t* Wsb = (bf16_t*)(ws + WS_WS);
    bf16_t* XN = (bf16_t*)(ws + WS_XN); bf16_t* Y = (bf16_t*)(ws + WS_Y); bf16_t* Kb = (bf16_t*)(ws + WS_K); bf16_t* Vb = (bf16_t*)(ws + WS_V);
    bf16_t* GAb = (bf16_t*)(ws + WS_GA); bf16_t* GBb = (bf16_t*)(ws + WS_GB); bf16_t* Qb = (bf16_t*)(ws + WS_Q); bf16_t* Ub = (bf16_t*)(ws + WS_U); bf16_t* VGb = (bf16_t*)(ws + WS_VG);
    bf16_t* AG = (bf16_t*)(ws + WS_AG); bf16_t* XN2 = (bf16_t*)(ws + WS_XN2); bf16_t* HM = (bf16_t*)(ws + WS_HM); bf16_t* W1s = (bf16_t*)(ws + WS_W1S);

    for (int u = tid; u < (LDS_BYTES - LDSCTL_OFF) / 4; u += NWAVES * 64) ((LAS unsigned*)(L + LDSCTL_OFF))[u] = 0u;
    __syncthreads();
    const int lo = args.ph_lo, hi = args.ph_hi;
    XcdBarrier bar; bar.bar = (unsigned*)(ws + WS_CTL) + CW_BAR; bar.x = 0; bar.st = nullptr;
    if (hi - lo > 1) bar = xcd_barrier_post((unsigned*)(ws + WS_CTL) + CW_BAR, MISC + 8);
#define IN(k) (lo <= (k) && (k) < hi)
#define SEAM(k) do { if (IN(k) && IN((k) + 1)) xcd_barrier(bar); } while (0)

    if (IN(0)) {
        LAS float* scr = (LAS float*)(L + RING_OFF);
        if (vcu < NMOD / 32) gemv32<5, true>(c, c + DM, c + 2 * DM, c + 3 * DM, c_ctx, w_mod, NMOD, 32 * vcu, b_mod, mod, NMOD, scr, wave, lane);
    }
    SEAM(0);
    constexpr int I_IN = 16 * 120, I_BA = 8 * 32, I_BG = 8 * 32, I_O = 16 * 32, I_1 = 16 * 128, I_2 = 64 * 32, I_WS = 256, I_RP = 32;
    if (IN(1)) {
        {
            const int gw = vcu * NWAVES + wave, NGW = G * NWAVES;
            for (int m = gw; m < MTOK + MCTX; m += NGW) { const float* xr = m < MTOK ? x + (size_t)m * DM : ctx + (size_t)(m - MTOK) * DM; const float* mv = mod + (size_t)(m < MTOK ? m / SEQ : 4) * NMOD;
                norm_mod_row(xr, norm1_g, mv, mv + DM, XN + (size_t)m * DM, ws + WS_XN8 + (size_t)m * DM, lane); }
        }
        {
            LAS float* wscr = (LAS float*)(L + RING_OFF + wave * 16384);
            unsigned* iq = (unsigned*)(ws + WS_CTL) + 128;
            for (;;) {
                __syncthreads();
                if (tid == 0) MISC[17] = __hip_atomic_fetch_add(iq, (unsigned)NWAVES, __ATOMIC_RELAXED, __HIP_MEMORY_SCOPE_AGENT);
                __syncthreads();
                const int it0 = (int)MISC[17];
                if (it0 >= I_IN + I_WS + I_RP) break;
                int r = it0 + wave;
                if (r >= I_IN + I_WS + I_RP) continue;
                if (r < I_IN) { const int kb = r / 120, nb = r % 120, n0 = 32 * nb, within = n0 & 255; const int gcol = n0 >= COL_GB ? n0 - COL_GB : n0 - COL_GA;
                    const int drow0 = n0 >= COL_GA ? 256 * (7 + (gcol >> 7)) + (n0 >= COL_GB ? 128 : 0) + (gcol & 127) : (n0 & ~255) + 128 * ((within & 63) >> 5) + 32 * (within >> 6);
                    transpose_item(w_in, D_IN, 64 * kb, n0, Win_t, DM, drow0, 64 * kb, wscr, lane, ws + WS_WIN8); continue; } r -= I_IN;
                if (r < I_WS) { const int e0 = r * 512 + lane * 8; const f32x4 a = *(const f32x4*)(gm_ws + e0), b = *(const f32x4*)(gm_ws + e0 + 4);
                    v4u o; o.x = pk2(a.x, a.y); o.y = pk2(a.z, a.w); o.z = pk2(b.x, b.y); o.w = pk2(b.z, b.w); *(v4u*)(Wsb + e0) = o; continue; } r -= I_WS;
                { const int i = r * 64 + lane, pos = i >> 4, j = i & 15; const float inv = powf(10000.0f, -(float)(2 * j) / 32.0f); const float ang = (float)pos * inv;
                  rope[pos * 32 + j] = cosf(ang); rope[pos * 32 + 16 + j] = sinf(ang); }
            }
        }
    }
    SEAM(1);
    float mq = 0.f, mk = 0.f;
    for (int d = 0; d < HD; ++d) { mq = fmaxf(mq, fabsf(q_norm_g[d])); mk = fmaxf(mk, fabsf(k_norm_g[d])); }
    const bool noref = (64.0f * QSCALE_LOG2E * mq * mk) <= 50.0f;
    const bool pv8 = (64.0f * QSCALE_LOG2E * mq * mk) <= 14.0f;
    if (IN(2)) {
        pg8::EpiInProj E{Kb, Vb, Qb, Ub, VGb, GAb, GBb, q_norm_g, k_norm_g, gm_norm_g, rope, ws + WS_K8, ws + WS_Q8, ws + WS_V8T, (noref && pv8) ? 1 : 0};
        {
            pg8::Gemm g8{(const bf16_t*)(ws + WS_XN8), (const bf16_t*)(ws + WS_WIN8), DM / 2, DM / 2, DM / 2}; pg8::OrderInProjF8 S8; S8.init(G, bx);
            pg8::gemm_phase<pg8::EpiInProj, pg8::OrderInProjF8, true, true>(L + RING_OFF, g8, S8, E); }
        pg8::Gemm g{XN, Win_t, DM, DM, DM}; pg8::OrderInProjBf S; S.init(G, bx);
        pg8::gemm_phase<pg8::EpiInProj, pg8::OrderInProjBf, true>(L + RING_OFF, g, S, E);
        {
            const int rem = (128 * 15 + 4) % G; const bool spare = rem == 0 || bx >= rem; const int n_sp = rem == 0 ? G : G - rem, idx = rem == 0 ? bx : bx - rem;
            if (spare) {
                LAS float* scr = (LAS float*)(L + RING_OFF);
                for (int cgp = idx; cgp < D_FF / 32; cgp += n_sp) gemv32<4, false>(mod + 3 * DM, mod + NMOD + 3 * DM, mod + 2 * NMOD + 3 * DM, mod + 3 * NMOD + 3 * DM, nullptr, w_ff1, D_FF, 32 * cgp, nullptr, cvec, D_FF, scr, wave, lane);
                LAS float* wscr = (LAS float*)(L + RING_OFF + wave * 16384);
                for (int it = idx * NWAVES + wave; it < I_BA + I_BG + I_O + I_1 + I_2; it += n_sp * NWAVES) {
                    int r = it;
                    if (r < I_BA) { transpose_item(w_br_attn, DM, 64 * (r / 32), 32 * (r % 32), Wm_t, DM, 32 * (r % 32), 64 * (r / 32), wscr, lane); continue; } r -= I_BA;
                    if (r < I_BG) { transpose_item(w_br_gm, DM, 64 * (r / 32), 32 * (r % 32), Wm_t, DM, 32 * (r % 32), 512 + 64 * (r / 32), wscr, lane); continue; } r -= I_BG;
                    if (r < I_O) { transpose_item(w_out, DM, 64 * (r / 32), 32 * (r % 32), Wout_t, DM, 32 * (r % 32), 64 * (r / 32), wscr, lane); continue; } r -= I_O;
                    if (r < I_1) { transpose_item_w1(w_ff1, 64 * (r / 128), 32 * (r % 128), W1s, norm2_g, mod, wscr, lane); continue; } r -= I_1;
                    transpose_item(w_ff2, DM, 64 * (r / 32), 32 * (r % 32), W2_t, D_FF, 32 * (r % 32), 64 * (r / 32), wscr, lane);
                }
            }
        }
    }
    SEAM(2);
    if (IN(3)) {
        const attn_body::AttnTensors AT{(const attn_body::bf16*)Qb, (const attn_body::bf16*)Kb, (const attn_body::bf16*)Vb, (attn_body::bf16*)AG, ws + WS_Q8, ws + WS_K8, ws + WS_V8T};
        const attn_body::StaticOrder S(vcu, G);
        attn_body::attn_phase<attn_body::StaticOrder>((char*)lds + RING_OFF, AT, S, noref, pv8);
        {
            unsigned* gq = (unsigned*)(ws + WS_CTL) + 64;
            for (;;) {
                __syncthreads();
                if (tid == 0) MISC[16] = __hip_atomic_fetch_add(gq, 1u, __ATOMIC_RELAXED, __HIP_MEMORY_SCOPE_AGENT);
                __syncthreads();
                const int ch = (int)MISC[16];
                if (ch >= MTOK / 128) break;
                gmlp_unit(ch, wave, Ub, VGb, Wsb, gm_bs, AG, L + RING_OFF + wave * 16384, lane);
            }
        }
#ifdef ABL_PROBE
        { attn_body::AttnUnit pu; if (S.next(0, pu)) attn_body::attn_unit<8, true, ABL_PROBE>(pu.b, pu.h, pu.qb, AT.Q, AT.K, AT.V, (attn_body::bf16*)XN2, (char*)lds + RING_OFF); }
#endif
    }
    SEAM(3);
    if (IN(4)) {
        pg8::Gemm g{AG, Wm_t, DM, DM, 512}; pg8::OrderMerge S; S.init(MTOK / 256, DM / 256, G, bx);
        pg8::EpiMerge E{GAb, GBb, Y};
        pg8::gemm_phase<pg8::EpiMerge, pg8::OrderMerge, true>(L + RING_OFF, g, S, E);
    }
    SEAM(4);
    if (IN(5)) {
        pg8::Gemm g{Y, Wout_t, DM, DM, DM}; pg8::OrderPlain S; S.init(MTOK / 256, DM / 256, G, bx);
        pg8::EpiOutProj E{x, XN2, ssq, mod};
        pg8::gemm_phase<pg8::EpiOutProj, pg8::OrderPlain, true>(L + RING_OFF, g, S, E);
    }
    SEAM(5);
    if (IN(6)) {
        pg8::Gemm g{XN2, W1s, DM, DM, DM}; pg8::OrderBatchB S; S.init(MTOK / 256, D_FF / 256, G, bx, (long)D_FF * DM * 2);
        pg8::EpiFfnUp E{HM, ssq, cvec};
        pg8::gemm_phase<pg8::EpiFfnUp, pg8::OrderBatchB, true>(L + RING_OFF, g, S, E);
    }
    SEAM(6);
    if (IN(7)) {
        pg8::Gemm g{HM, W2_t, D_FF, D_FF, D_FF}; pg8::OrderPlain S; S.init(MTOK / 256, DM / 256, G, bx, 1);
        pg8::EpiFfnDown E{out, XN2, mod};
        pg8::gemm_phase<pg8::EpiFfnDown, pg8::OrderPlain, true>(L + RING_OFF, g, S, E);
    }
#undef IN
#undef SEAM
}

extern "C" void kernel_launch(void* const* d_in, const int* in_sizes, int n_in, void* d_out, int out_size, void* d_ws, size_t ws_size, hipStream_t stream) {
    if (n_in != 19 || in_sizes[0] != MTOK * DM || out_size != MTOK * DM || ws_size < WS_END) { fprintf(stderr, "kernel_launch: unexpected shapes (n_in %d, in0 %d, out %d, ws %zu)\n", n_in, n_in > 0 ? in_sizes[0] : -1, out_size, ws_size); return; }
    static int grid = 0;
    if (grid == 0) {
        int dev = 0, cus = 0, per_cu = 0;
        if (hipGetDevice(&dev) != hipSuccess || hipDeviceGetAttribute(&cus, hipDeviceAttributeMultiprocessorCount, dev) != hipSuccess) { fprintf(stderr, "kernel_launch: device query failed\n"); grid = -1; return; }
        if (hipFuncSetAttribute((const void*)mega_fwd, hipFuncAttributeMaxDynamicSharedMemorySize, LDS_BYTES) != hipSuccess) { fprintf(stderr, "kernel_launch: hipFuncSetAttribute failed\n"); grid = -1; return; }
        if (hipOccupancyMaxActiveBlocksPerMultiprocessor(&per_cu, (const void*)mega_fwd, NWAVES * 64, LDS_BYTES) != hipSuccess || per_cu < 1) fprintf(stderr, "kernel_launch: occupancy query reports %d blocks per CU\n", per_cu);
        (void)hipGetLastError();
        grid = cus;
    }
    if (grid < 0) return;
    Args a{};
    for (int i = 0; i < 19; ++i) a.in[i] = (const float*)d_in[i];
    a.out = (float*)d_out; a.ws = (unsigned char*)d_ws;
    (void)hipMemsetAsync((char*)d_ws + WS_CTL, 0, CTL_ZERO_BYTES, stream);
    a.ph_lo = 0; a.ph_hi = NPHASE;
    hipLaunchKernelGGL(mega_fwd, dim3(grid), dim3(NWAVES * 64), LDS_BYTES, stream, a);
}
```

```cpp
#include <hip/hip_runtime.h>
#include <cstdio>
#include <cstdint>

typedef unsigned short bf16_t;

constexpr int DM = 1024, BATCH = 4, SEQ = 8192, GRID_W = 64, CTX = 256, HD = 64, NQH = 8, NKVH = 2;
constexpr int MTOK = BATCH * SEQ;
constexpr int MCTX = BATCH * CTX;
constexpr int NKEY = CTX + SEQ;
constexpr int D_IN = 3840, D_FF = 4096, NMOD = 6 * DM;
constexpr int COL_K = 0, COL_V = 128, COL_Q = 256, COL_U = 768, COL_VG = 1280, COL_GA = 1792, COL_GB = 2816;
constexpr float EPS = 1e-6f;
constexpr float QSCALE_LOG2E = 0.125f * 1.4426950408889634f;

constexpr size_t MiB = 1u << 20;
constexpr size_t WS_CTL = 0;
constexpr size_t WS_MOD = 1 * MiB;
constexpr size_t WS_CVEC = WS_MOD + 128 * 1024;
constexpr size_t WS_ROPE = WS_CVEC + 64 * 1024;
constexpr size_t WS_WIN = 2 * MiB, WS_WM = 10 * MiB, WS_WOUT = 12 * MiB, WS_W1 = 14 * MiB, WS_W2 = 22 * MiB, WS_WS = 30 * MiB, WS_SSQ = 31 * MiB;
constexpr size_t WS_XN = 34 * MiB;
constexpr size_t WS_Y = WS_XN;
constexpr size_t WS_K = 100 * MiB, WS_V = 109 * MiB;
constexpr size_t WS_GA = 118 * MiB, WS_GB = 182 * MiB;
constexpr size_t WS_Q = 246 * MiB, WS_U = 278 * MiB, WS_VG = 310 * MiB;
constexpr size_t WS_XN8 = 342 * MiB, WS_WIN8 = 14 * MiB;
constexpr size_t WS_AG = 342 * MiB;
constexpr size_t WS_XN2 = 406 * MiB;
constexpr size_t WS_K8 = WS_XN2, WS_Q8 = WS_XN2 + 8 * MiB, WS_V8T = WS_XN2 + 26 * MiB;
constexpr size_t WS_HM = 34 * MiB;
constexpr size_t WS_W1S = 470 * MiB;
constexpr size_t WS_END = 502 * MiB;

__device__ __forceinline__ float bf2f(bf16_t v) { return __uint_as_float(((unsigned)v) << 16); }
__device__ __forceinline__ bf16_t f2bf(float f) { unsigned u = __float_as_uint(f); return (bf16_t)((u + 0x7fffu + ((u >> 16) & 1u)) >> 16); }
__device__ __forceinline__ float siluf_(float x) { return x / (1.0f + __expf(-x)); }
__device__ __forceinline__ float wave_sum(float v) {
#pragma unroll
    for (int o = 1; o < 64; o <<= 1) v += __shfl_xor(v, o);
    return v;
}


namespace pg8 {
#define PG8_LAS __attribute__((address_space(3)))
typedef short bf16x8 __attribute__((ext_vector_type(8)));
typedef float f32x4 __attribute__((ext_vector_type(4)));
typedef unsigned u32x4 __attribute__((ext_vector_type(4)));
typedef unsigned u32x2 __attribute__((ext_vector_type(2)));
typedef int v4i_t __attribute__((ext_vector_type(4)));
constexpr int BM = 256, BK = 64, HALF = 128, HTB = HALF * BK * 2  , STAGE_BYTES = 8 * HTB, NXCD = 8, WGM = 8;

__host__ __device__ __forceinline__ int lds_byte(int r, int c) { const int st = (r >> 4) * 2 + (c >> 5), rr = r & 15, cc = c & 31, ob = rr * 64 + cc * 2; return st * 1024 + (ob ^ (((ob >> 9) & 1) << 5)); }
__host__ __device__ __forceinline__ void stage_rc(int b, int& R, int& C) { const int st = b / 1024, sb = b % 1024, swz = sb ^ (((sb >> 9) & 1) << 5); R = (st >> 1) * 16 + swz / 64; C = (st & 1) * 32 + (swz % 64) / 2; }
__host__ __device__ __forceinline__ int perm32(int rho) { const int n = rho >> 4, i = rho & 15; return 8 * (i >> 2) + 4 * n + (i & 3); }

struct Unit { int pm, pn, ko, keep; long bofs; };
struct Gemm { const bf16_t* A; const bf16_t* Bt; int lda, ldb, K; };

struct TileOrder {
    int nM, nN, nwg;
    __device__ __forceinline__ void init(int nM_, int nN_) { nM = nM_; nN = nN_; nwg = nM * nN; }
    __device__ __forceinline__ void tile(int L, int& pm, int& pn) const {
        int wgid = L; { const int q = nwg / NXCD, r = nwg % NXCD, xcd = wgid % NXCD, off = wgid / NXCD; wgid = (xcd < r ? xcd * (q + 1) : r * (q + 1) + (xcd - r) * q) + off; }
        const int nig = WGM * nN, gid = wgid / nig, fm = gid * WGM, gsz = (nM - fm) < WGM ? (nM - fm) : WGM;
        pm = fm + ((wgid % nig) % gsz); pn = (wgid % nig) / gsz;
    }
};
struct OrderPlain {
    static constexpr bool KEEPS = false;
    TileOrder T; int G, c, rev;
    __device__ __forceinline__ void init(int nM, int nN, int G_, int c_, int rev_ = 0) { T.init(nM, nN); G = G_; c = c_; rev = rev_; }
    __device__ __forceinline__ bool next(int i, Unit& u) const { const int nr = T.nwg / G; if (i >= nr) return false; const int L = (rev ? nr - 1 - i : i) * G + c; if (L >= T.nwg) return false; T.tile(L, u.pm, u.pn); u.ko = 0; u.keep = 0; u.bofs = 0; return true; }
};
struct OrderBatchB {
    static constexpr bool KEEPS = false;
    TileOrder T; int G, c; long bstride;
    __device__ __forceinline__ void init(int nM, int nN, int G_, int c_, long bs) { T.init(nM, nN); G = G_; c = c_; bstride = bs; }
    __device__ __forceinline__ bool next(int i, Unit& u) const { const int L = i * G + c; if (L >= T.nwg) return false; T.tile(L, u.pm, u.pn); u.ko = 0; u.keep = 0; u.bofs = (long)(u.pm >> 5) * bstride; return true; }
};
struct OrderInProj {
    static constexpr bool KEEPS = false;
    TileOrder T; int G, c;
    __device__ __forceinline__ void init(int G_, int c_) { T.init(128, 15); G = G_; c = c_; }
    __device__ __forceinline__ bool next(int i, Unit& u) const { const int L = i * G + c; u.ko = 0; u.keep = 0; u.bofs = 0;
        if (L < T.nwg) { T.tile(L, u.pm, u.pn); return true; } if (L < T.nwg + 4) { u.pm = 128 + (L - T.nwg); u.pn = 0; return true; } return false; }
};
#ifndef IN_F8_TILES
#define IN_F8_TILES 11
#endif
struct OrderInProjF8 {
    static constexpr bool KEEPS = false;
    TileOrder T; int G, c;
    __device__ __forceinline__ void init(int G_, int c_) { T.init(128, IN_F8_TILES); G = G_; c = c_; }
    __device__ __forceinline__ bool next(int i, Unit& u) const { const int L = i * G + c; u.ko = 0; u.keep = 0; u.bofs = 0;
        if (L < T.nwg) { int j; T.tile(L, u.pm, j); u.pn = j < 3 ? j : j + 4; return true; } if (L < T.nwg + 4) { u.pm = 128 + (L - T.nwg); u.pn = 0; return true; } return false; }
};
struct OrderInProjBf {
    static constexpr bool KEEPS = false;
    TileOrder T; int G, c;
    __device__ __forceinline__ void init(int G_, int c_) { T.init(128, 15 - IN_F8_TILES); G = G_; c = c_; }
    __device__ __forceinline__ bool next(int i, Unit& u) const { const int L = i * G + c; u.ko = 0; u.keep = 0; u.bofs = 0; if (L >= T.nwg) return false; int j; T.tile(L, u.pm, j); u.pn = 3 + j; return true; }
};
struct OrderMerge {
    static constexpr bool KEEPS = true;
    TileOrder T; int G, c;
    __device__ __forceinline__ void init(int nM, int nN, int G_, int c_) { T.init(nM, nN); G = G_; c = c_; }
    __device__ __forceinline__ bool next(int i, Unit& u) const { const int L = (i >> 1) * G + c; if (L >= T.nwg) return false; T.tile(L, u.pm, u.pn); u.ko = (i & 1) * 512; u.keep = (i & 1) ^ 1; u.bofs = 0; return true; }
};

__device__ __forceinline__ unsigned cvt_pk_bf16(float lo, float hi) { unsigned r; asm volatile("v_cvt_pk_bf16_f32 %0, %1, %2" : "=v"(r) : "v"(lo), "v"(hi)); return r; }
__device__ __forceinline__ float bf_lo(unsigned w) { return __uint_as_float(w << 16); }
__device__ __forceinline__ float bf_hi(unsigned w) { return __uint_as_float(w & 0xffff0000u); }
__device__ __forceinline__ float fast_rcp(float x) { return __builtin_amdgcn_rcpf(x); }
__device__ __forceinline__ float gelu_fast(float x) { const float u = x * (0.7978845608028654f + 0.0356774081363001f * x * x); return x * fast_rcp(1.0f + __builtin_amdgcn_exp2f(-2.885390081777927f * u)); }
__device__ __forceinline__ float sigmoid_fast(float x) { return fast_rcp(1.0f + __builtin_amdgcn_exp2f(-1.4426950408889634f * x)); }


struct EpiInProj {
    static constexpr bool PERM = true, AFTER_DRAIN = false;
    bf16_t *Kb, *Vb, *Qb, *Ub, *VGb, *GAb, *GBb; const float *qg, *kg, *gmg, *rope; unsigned char *K8, *Q8, *V8T; int skip16;
    __device__ __forceinline__ void operator()(f32x4 (&acc)[2][2][4][2], const Unit& u, int wr, int wc, int fr, int fq) const {
        const bool ctx = u.pm >= 128;
        const int hh = 4 * u.pn + wc;
        const int dl = 8 * fq;
        f32x4 gv[2][2];
        const bool is_k = hh < 2, is_q = (hh >= 4 && hh < 12), is_vg = (hh >= 20 && hh < 28);
        if (is_k || is_q || is_vg) { const float* g = is_k ? kg : (is_q ? qg : gmg + (hh - 20) * 64);
#pragma unroll
            for (int bj = 0; bj < 2; ++bj)
#pragma unroll
                for (int n = 0; n < 2; ++n) gv[bj][n] = *(const f32x4*)(g + 32 * bj + dl + 4 * n); }
        else {
#pragma unroll
            for (int bj = 0; bj < 2; ++bj)
#pragma unroll
                for (int n = 0; n < 2; ++n) gv[bj][n] = (f32x4){1.f, 1.f, 1.f, 1.f}; }
        bf16_t* dbase; int pitch;
        if (hh < 2) { dbase = Kb + hh * 64; pitch = 128; } else if (hh < 4) { dbase = Vb + (hh - 2) * 64; pitch = 128; }
        else if (hh < 12) { dbase = Qb + (hh - 4) * 64; pitch = 512; } else if (hh < 20) { dbase = Ub + (hh - 12) * 64; pitch = 512; }
        else if (hh < 28) { dbase = VGb + (hh - 20) * 64; pitch = 512; } else { dbase = GAb + (u.pn - 7) * 128 + wc * 32; pitch = 1024; }
        const bool kv = hh < 4;
        const size_t rowbase = ctx ? (size_t)(u.pm - 128) * NKEY : (kv ? (size_t)(u.pm >> 5) * NKEY + CTX + (size_t)(u.pm & 31) * 256 : (size_t)u.pm * 256);
#pragma unroll
        for (int ai = 0; ai < 2; ++ai)
#pragma unroll
            for (int m = 0; m < 4; ++m) {
                const int rt = ai * HALF + wr * 64 + m * 16 + fr;
                f32x4 v[2][2];
#pragma unroll
                for (int bj = 0; bj < 2; ++bj)
#pragma unroll
                    for (int n = 0; n < 2; ++n) v[bj][n] = acc[ai][bj][m][n];
                if (hh >= 28) {
#pragma unroll
                    for (int n = 0; n < 2; ++n)
#pragma unroll
                        for (int e = 0; e < 4; ++e) { const float ea = __builtin_amdgcn_exp2f(fminf(-1.4426950408889634f * v[0][n][e], 60.f)), eb = __builtin_amdgcn_exp2f(fminf(-1.4426950408889634f * v[1][n][e], 60.f));
                            v[0][n][e] = (1.0f + eb) * fast_rcp(1.0f + ea); v[1][n][e] = fast_rcp(1.0f + eb); }
                } else if (hh >= 12) {
#pragma unroll
                    for (int bj = 0; bj < 2; ++bj)
#pragma unroll
                        for (int n = 0; n < 2; ++n)
#pragma unroll
                            for (int e = 0; e < 4; ++e) v[bj][n][e] = gelu_fast(v[bj][n][e]);
                }
                if (is_k || is_q || is_vg) {
                    float s = 0.f;
#pragma unroll
                    for (int bj = 0; bj < 2; ++bj)
#pragma unroll
                        for (int n = 0; n < 2; ++n) { const f32x4 x = v[bj][n]; s += (x[0] * x[0] + x[1] * x[1]) + (x[2] * x[2] + x[3] * x[3]); }
                    s += __shfl_xor(s, 16); s += __shfl_xor(s, 32);
                    const float rstd = __builtin_amdgcn_rsqf(s * (1.0f / 64.0f) + EPS);
#pragma unroll
                    for (int bj = 0; bj < 2; ++bj)
#pragma unroll
                        for (int n = 0; n < 2; ++n) v[bj][n] = v[bj][n] * rstd * gv[bj][n];
                    if ((is_k || is_q) && !ctx) {
                        const int prow = (4 * u.pm + 2 * ai + wr) & 127, pcol = m * 16 + fr;
                        const float* tp = rope + (fq < 2 ? prow : pcol) * 32 + 8 * (fq & 1);
#pragma unroll
                        for (int n = 0; n < 2; ++n) { const f32x4 cs = *(const f32x4*)(tp + 4 * n), sn = *(const f32x4*)(tp + 16 + 4 * n);
                            const f32x4 x1 = v[0][n], x2 = v[1][n]; v[0][n] = x1 * cs - x2 * sn; v[1][n] = x2 * cs + x1 * sn; }
                    }
                    if (is_q) {
#pragma unroll
                        for (int bj = 0; bj < 2; ++bj)
#pragma unroll
                            for (int n = 0; n < 2; ++n) v[bj][n] = v[bj][n] * QSCALE_LOG2E;
                    }
                }
                if (is_k || is_q) {
                    unsigned char* p8 = (is_k ? K8 + hh * 64 + (rowbase + rt) * (size_t)128 : Q8 + (hh - 4) * 64 + (rowbase + rt) * (size_t)512) + dl;
#pragma unroll
                    for (int bj = 0; bj < 2; ++bj) { int lo = __builtin_amdgcn_cvt_pk_fp8_f32(v[bj][0][0], v[bj][0][1], 0, false); lo = __builtin_amdgcn_cvt_pk_fp8_f32(v[bj][0][2], v[bj][0][3], lo, true);
                        int hi2 = __builtin_amdgcn_cvt_pk_fp8_f32(v[bj][1][0], v[bj][1][1], 0, false); hi2 = __builtin_amdgcn_cvt_pk_fp8_f32(v[bj][1][2], v[bj][1][3], hi2, true);
                        u32x2 w8; w8.x = (unsigned)lo; w8.y = (unsigned)hi2; *(u32x2*)(p8 + 32 * bj) = w8; }
                }
                if (hh == 2 || hh == 3) {
                    const int kk = m * 16 + fr, p8 = 32 * ((kk >> 2) & 1) + (kk & 3) + 4 * ((kk & 31) >> 3) + 16 * (kk >> 5);
                    const size_t tile = (ctx ? (size_t)(u.pm - 128) * 264 : (size_t)(u.pm >> 5) * 264 + 4 + 4 * (u.pm & 31)) + (size_t)(hh - 2) * 132 + 2 * ai + wr;
                    unsigned char* vt = V8T + tile * 4096 + p8;
#pragma unroll
                    for (int bj = 0; bj < 2; ++bj)
#pragma unroll
                        for (int n = 0; n < 2; ++n) { const int w01 = __builtin_amdgcn_cvt_pk_fp8_f32(v[bj][n][0], v[bj][n][1], 0, false), w23 = __builtin_amdgcn_cvt_pk_fp8_f32(v[bj][n][2], v[bj][n][3], 0, false);
                            unsigned char* q = vt + (32 * bj + dl + 4 * n) * 64;
                            q[0] = (unsigned char)(w01 & 0xff); q[64] = (unsigned char)((w01 >> 8) & 0xff); q[128] = (unsigned char)(w23 & 0xff); q[192] = (unsigned char)((w23 >> 8) & 0xff); }
                }
                bf16_t* rowp = dbase + (rowbase + rt) * pitch + dl;
                if (!(skip16 && hh < 12))
#pragma unroll
                for (int bj = 0; bj < 2; ++bj) { u32x4 w; w.x = cvt_pk_bf16(v[bj][0][0], v[bj][0][1]); w.y = cvt_pk_bf16(v[bj][0][2], v[bj][0][3]); w.z = cvt_pk_bf16(v[bj][1][0], v[bj][1][1]); w.w = cvt_pk_bf16(v[bj][1][2], v[bj][1][3]);
                    *(u32x4*)(rowp + (hh >= 28 ? (GBb - GAb) * bj : 32 * bj)) = w; }
            }
    }
};
struct EpiMerge {
    static constexpr bool PERM = true, AFTER_DRAIN = false;
    const bf16_t *GAb, *GBb; bf16_t* Y;
    __device__ __forceinline__ void operator()(f32x4 (&acc)[2][2][4][2], const Unit& u, int wr, int wc, int fr, int fq) const {
        const int row0 = u.pm * BM + wr * 64 + fr, col0 = u.pn * BM + wc * 32 + 8 * fq;
#pragma unroll
        for (int ai = 0; ai < 2; ++ai) {
            u32x4 gb[4][2], ga[4][2];
#pragma unroll
            for (int m = 0; m < 4; ++m)
#pragma unroll
                for (int bj = 0; bj < 2; ++bj) { const size_t off = (size_t)(row0 + ai * HALF + m * 16) * 1024 + col0 + bj * HALF; if (u.keep) ga[m][bj] = *(const u32x4*)(GAb + off); else gb[m][bj] = *(const u32x4*)(GBb + off); }
            asm volatile("" ::: "memory");
#pragma unroll
            for (int m = 0; m < 4; ++m)
#pragma unroll
                for (int bj = 0; bj < 2; ++bj) { const size_t off = (size_t)(row0 + ai * HALF + m * 16) * 1024 + col0 + bj * HALF;
                    if (u.keep) {
#pragma unroll
                        for (int k = 0; k < 4; ++k) { const int n = k >> 1, e = (k & 1) * 2;
                            acc[ai][bj][m][n][e] *= bf_lo(ga[m][bj][k]); acc[ai][bj][m][n][e + 1] *= bf_hi(ga[m][bj][k]); }
                    } else { u32x4 w;
#pragma unroll
                        for (int k = 0; k < 4; ++k) { const int n = k >> 1, e = (k & 1) * 2; w[k] = cvt_pk_bf16(acc[ai][bj][m][n][e] * bf_lo(gb[m][bj][k]), acc[ai][bj][m][n][e + 1] * bf_hi(gb[m][bj][k])); }
                        *(u32x4*)(Y + off) = w; }
                }
            asm volatile("" ::: "memory");
        }
    }
};
struct EpiOutProj {
    static constexpr bool PERM = true, AFTER_DRAIN = false;
    const float* x; bf16_t* X1b; float* ssq; const float* mod;
    __device__ __forceinline__ void operator()(f32x4 (&acc)[2][2][4][2], const Unit& u, int wr, int wc, int fr, int fq) const {
        const int row0 = u.pm * BM + wr * 64 + fr, col0 = u.pn * BM + wc * 32 + 8 * fq;
        const float* mv = mod + (size_t)(u.pm >> 5) * NMOD;
        {
            f32x4 g1v[2][2];
#pragma unroll
            for (int bj = 0; bj < 2; ++bj)
#pragma unroll
                for (int n = 0; n < 2; ++n) g1v[bj][n] = *(const f32x4*)(mv + 2 * DM + col0 + bj * HALF + n * 4);
#pragma unroll
            for (int ai = 0; ai < 2; ++ai)
#pragma unroll
                for (int m = 0; m < 4; ++m)
#pragma unroll
                    for (int bj = 0; bj < 2; ++bj)
#pragma unroll
                        for (int n = 0; n < 2; ++n) acc[ai][bj][m][n] *= g1v[bj][n];
        }
        asm volatile("" ::: "memory");
#pragma unroll
        for (int ai = 0; ai < 2; ++ai) {
            f32x4 pre[4][2][2];
#pragma unroll
            for (int m = 0; m < 4; ++m)
#pragma unroll
                for (int bj = 0; bj < 2; ++bj)
#pragma unroll
                    for (int n = 0; n < 2; ++n) pre[m][bj][n] = *(const f32x4*)(x + (size_t)(row0 + ai * HALF + m * 16) * DM + col0 + bj * HALF + n * 4);
            asm volatile("" ::: "memory");
#pragma unroll
            for (int m = 0; m < 4; ++m) { const int r = row0 + ai * HALF + m * 16; bf16_t* op = X1b + (size_t)r * DM + col0; float s = 0.f;
#pragma unroll
                for (int bj = 0; bj < 2; ++bj) { const f32x4 a0 = pre[m][bj][0] + acc[ai][bj][m][0], a1 = pre[m][bj][1] + acc[ai][bj][m][1];
                    s += ((a0[0] * a0[0] + a0[1] * a0[1]) + (a0[2] * a0[2] + a0[3] * a0[3])) + ((a1[0] * a1[0] + a1[1] * a1[1]) + (a1[2] * a1[2] + a1[3] * a1[3]));
                    u32x4 w; w.x = cvt_pk_bf16(a0[0], a0[1]); w.y = cvt_pk_bf16(a0[2], a0[3]); w.z = cvt_pk_bf16(a1[0], a1[1]); w.w = cvt_pk_bf16(a1[2], a1[3]);
                    *(u32x4*)(op + bj * HALF) = w; }
                s += __shfl_xor(s, 16); s += __shfl_xor(s, 32);
                if (fq == 0) ssq[(size_t)r * 16 + u.pn * 4 + wc] = s; }
            asm volatile("" ::: "memory");
        }
    }
};
struct EpiFfnUp {
    static constexpr bool PERM = true, AFTER_DRAIN = false;
    bf16_t* H; const float* ssq; const float* cvec;
    __device__ __forceinline__ void operator()(f32x4 (&acc)[2][2][4][2], const Unit& u, int wr, int wc, int fr, int fq) const {
        const int row0 = u.pm * BM + wr * 64 + fr, col0 = u.pn * BM + wc * 32 + 8 * fq;
        const float* cv = cvec + (size_t)(u.pm >> 5) * D_FF + col0;
        f32x4 bv[2][2], pp[2][4];
#pragma unroll
        for (int ai = 0; ai < 2; ++ai)
#pragma unroll
            for (int m = 0; m < 4; ++m) pp[ai][m] = *(const f32x4*)(ssq + (size_t)(row0 + ai * HALF + m * 16) * 16 + 4 * fq);
#pragma unroll
        for (int bj = 0; bj < 2; ++bj)
#pragma unroll
            for (int n = 0; n < 2; ++n) bv[bj][n] = *(const f32x4*)(cv + bj * HALF + 4 * n);
        asm volatile("" ::: "memory");
#pragma unroll
        for (int ai = 0; ai < 2; ++ai)
#pragma unroll
            for (int m = 0; m < 4; ++m) { const int r = row0 + ai * HALF + m * 16;
                const f32x4 p = pp[ai][m]; float s = (p[0] + p[1]) + (p[2] + p[3]);
                s += __shfl_xor(s, 16); s += __shfl_xor(s, 32);
                const float rstd = __builtin_amdgcn_rsqf(s * (1.0f / DM) + EPS);
                bf16_t* rowp = H + ((size_t)(u.pm * (D_FF / 256) + u.pn) * 65536) + (size_t)(r - u.pm * BM) * 256 + (col0 - u.pn * BM);
#pragma unroll
                for (int bj = 0; bj < 2; ++bj) { f32x4 v0 = acc[ai][bj][m][0] * rstd + bv[bj][0], v1 = acc[ai][bj][m][1] * rstd + bv[bj][1];
#pragma unroll
                    for (int e = 0; e < 4; ++e) { const float a = fmaxf(v0[e], 0.f), b = fmaxf(v1[e], 0.f); v0[e] = a * a; v1[e] = b * b; }
                    u32x4 w; w.x = cvt_pk_bf16(v0[0], v0[1]); w.y = cvt_pk_bf16(v0[2], v0[3]); w.z = cvt_pk_bf16(v1[0], v1[1]); w.w = cvt_pk_bf16(v1[2], v1[3]);
                    *(u32x4*)(rowp + bj * HALF) = w; } }
    }
};
struct EpiFfnDown {
    static constexpr bool PERM = true, AFTER_DRAIN = false;
    float* out; const bf16_t* X1b; const float* mod;
    __device__ __forceinline__ void operator()(f32x4 (&acc)[2][2][4][2], const Unit& u, int wr, int wc, int fr, int fq) const {
        const int row0 = u.pm * BM + wr * 64 + fr, col0 = u.pn * BM + wc * 32 + 8 * fq;
        const float* mv = mod + (size_t)(u.pm >> 5) * NMOD + 5 * DM;
        f32x4 g2v[2][2];
#pragma unroll
        for (int bj = 0; bj < 2; ++bj)
#pragma unroll
            for (int n = 0; n < 2; ++n) g2v[bj][n] = *(const f32x4*)(mv + col0 + bj * HALF + n * 4);
        u32x4 pre[2][4][2];
#pragma unroll
        for (int ai = 0; ai < 2; ++ai)
#pragma unroll
            for (int m = 0; m < 4; ++m)
#pragma unroll
                for (int bj = 0; bj < 2; ++bj) pre[ai][m][bj] = *(const u32x4*)(X1b + (size_t)(row0 + ai * HALF + m * 16) * DM + col0 + bj * HALF);
        asm volatile("" ::: "memory");
#pragma unroll
        for (int ai = 0; ai < 2; ++ai)
#pragma unroll
            for (int m = 0; m < 4; ++m) { float* op = out + (size_t)(row0 + ai * HALF + m * 16) * DM + col0;
#pragma unroll
                for (int bj = 0; bj < 2; ++bj) { const u32x4 p = pre[ai][m][bj];
                    const f32x4 r0 = (f32x4){bf_lo(p[0]), bf_hi(p[0]), bf_lo(p[1]), bf_hi(p[1])}, r1 = (f32x4){bf_lo(p[2]), bf_hi(p[2]), bf_lo(p[3]), bf_hi(p[3])};
                    *(f32x4*)(op + bj * HALF) = r0 + g2v[bj][0] * acc[ai][bj][m][0]; *(f32x4*)(op + bj * HALF + 4) = r1 + g2v[bj][1] * acc[ai][bj][m][1]; } }
    }
};

template <class Epi, class Sched, bool ALIGN_EPI, bool F8 = false, bool TA = false>
__device__ __forceinline__ void gemm_phase(PG8_LAS unsigned char* lds, const Gemm g, const Sched& S, const Epi& E) {
    int tid_ = threadIdx.x; asm volatile("" : "+v"(tid_));
    const int tid = tid_, wid = __builtin_amdgcn_readfirstlane(tid >> 6), lane = tid & 63, wr = wid >> 2, wc = wid & 3, fr = lane & 15, fq = lane >> 4;
    const int nt = g.K / BK;
    constexpr bool ZEROC = !Sched::KEEPS;
    unsigned voffA[2], voffB[2];
#pragma unroll
    for (int i = 0; i < 2; ++i) { int R, C; stage_rc(tid * 16 + i * 8192, R, C); const int Rb = Epi::PERM ? ((R & ~31) + perm32(R & 31)) : R;
        voffA[i] = (unsigned)(R * g.lda + C) * 2u; voffB[i] = (unsigned)(Rb * g.ldb + C) * 2u; }
    const size_t kstep = (size_t)(BK * 2);
    const size_t hstepA = (size_t)HALF * g.lda * 2, hstepB = (size_t)HALF * g.ldb * 2;
    const size_t tstepA = TA ? (size_t)(g.K / 256) * 131072 : 2 * hstepA, tstepB = 2 * hstepB;
#define PG8_KOFFA(t) (TA ? (size_t)((t) >> 2) * 131072 + (size_t)((t) & 3) * kstep : (size_t)(t) * kstep)
    const unsigned ldsw = (unsigned)wid * 1024u;
    const int aoff = lds_byte(wr * 64 + fr, fq * 8), boff = lds_byte(wc * 32 + fr, fq * 8);
#define PG8_SA(b, h) (((b) * 2 + (h)) * HTB)
#define PG8_SB(b, h) ((4 + (b) * 2 + (h)) * HTB)
#define PG8_STAGE(bufoff, gbase, voff) do { _Pragma("unroll") for (int _i = 0; _i < 2; ++_i) { unsigned keep_; \
        asm volatile("s_mov_b32 %0, m0\n\ts_mov_b32 m0, %3\n\ts_nop 0\n\tglobal_load_lds_dwordx4 %1, %2\n\ts_mov_b32 m0, %0" \
            : "=&s"(keep_) : "v"((voff)[_i]), "s"((const char*)(gbase)), "s"((unsigned)(size_t)(lds + (bufoff) + ldsw + _i * 8192)) : "memory"); } } while (0)
#define PG8_LDA(dst, b, h) do { _Pragma("unroll") for (int m = 0; m < 4; ++m) _Pragma("unroll") for (int k = 0; k < 2; ++k) dst[m][k] = *(const PG8_LAS bf16x8*)(lds + PG8_SA(b, h) + aoff + m * 2048 + k * 1024); } while (0)
#define PG8_LDB(dst, b, h) do { _Pragma("unroll") for (int n = 0; n < 2; ++n) _Pragma("unroll") for (int k = 0; k < 2; ++k) dst[n][k] = *(const PG8_LAS bf16x8*)(lds + PG8_SB(b, h) + boff + n * 2048 + k * 1024); } while (0)
#define PG8_CAT(x0, x1) __builtin_shufflevector(__builtin_bit_cast(v4i_t, x0), __builtin_bit_cast(v4i_t, x1), 0, 1, 2, 3, 4, 5, 6, 7)
#define PG8_MMA(ai, bj, At, Bt) do { __builtin_amdgcn_s_setprio(1); \
        if constexpr (F8) { _Pragma("unroll") for (int m = 0; m < 4; ++m) _Pragma("unroll") for (int n = 0; n < 2; ++n) \
            asm volatile("v_mfma_f32_16x16x128_f8f6f4 %0, %1, %2, %0" : "+v"(acc[ai][bj][m][n]) : "v"(PG8_CAT(Bt[n][0], Bt[n][1])), "v"(PG8_CAT(At[m][0], At[m][1]))); }   \
        else { _Pragma("unroll") for (int m = 0; m < 4; ++m) _Pragma("unroll") for (int n = 0; n < 2; ++n) _Pragma("unroll") for (int k = 0; k < 2; ++k) \
            acc[ai][bj][m][n] = __builtin_amdgcn_mfma_f32_16x16x32_bf16(Bt[n][k], At[m][k], acc[ai][bj][m][n], 0, 0, 0); } \
        __builtin_amdgcn_s_setprio(0); } while (0)
#define PG8_MMA_Z(ai, bj, At, Bt) do { __builtin_amdgcn_s_setprio(1); \
        if constexpr (F8) { _Pragma("unroll") for (int m = 0; m < 4; ++m) _Pragma("unroll") for (int n = 0; n < 2; ++n) \
            asm volatile("v_mfma_f32_16x16x128_f8f6f4 %0, %1, %2, 0" : "=&v"(acc[ai][bj][m][n]) : "v"(PG8_CAT(Bt[n][0], Bt[n][1])), "v"(PG8_CAT(At[m][0], At[m][1]))); } \
        else { _Pragma("unroll") for (int m = 0; m < 4; ++m) _Pragma("unroll") for (int n = 0; n < 2; ++n) { \
            acc[ai][bj][m][n] = __builtin_amdgcn_mfma_f32_16x16x32_bf16(Bt[n][0], At[m][0], (f32x4){0.f, 0.f, 0.f, 0.f}, 0, 0, 0); \
            acc[ai][bj][m][n] = __builtin_amdgcn_mfma_f32_16x16x32_bf16(Bt[n][1], At[m][1], acc[ai][bj][m][n], 0, 0, 0); } } \
        __builtin_amdgcn_s_setprio(0); } while (0)
#define PG8_WAIT_V(n) asm volatile("s_waitcnt vmcnt(" #n ")" ::: "memory")
#define PG8_WAIT_L(n) asm volatile("s_waitcnt lgkmcnt(" #n ")" ::: "memory")
#define PG8_BAR __builtin_amdgcn_s_barrier()
#define PG8_SCHED __builtin_amdgcn_sched_barrier(0)
    Unit cur, nxt; int ui = 0;
    if (!S.next(0, cur)) return;
    f32x4 acc[2][2][4][2];
    if constexpr (!ZEROC) {
#pragma unroll
    for (int a = 0; a < 2; ++a)
#pragma unroll
        for (int b = 0; b < 2; ++b)
#pragma unroll
            for (int m = 0; m < 4; ++m)
#pragma unroll
                for (int n = 0; n < 2; ++n) acc[a][b][m][n] = (f32x4){0.f, 0.f, 0.f, 0.f};
    }
    bf16x8 At[4][2], B0[2][2], B1[2][2];
    const char* cA = (const char*)g.A + (size_t)cur.pm * tstepA + (size_t)cur.ko * 2; const char* cB = (const char*)g.Bt + (size_t)cur.pn * tstepB + (size_t)cur.ko * 2 + cur.bofs;
    PG8_STAGE(PG8_SB(0, 0), cB, voffB); PG8_STAGE(PG8_SB(0, 1), cB + hstepB, voffB); PG8_STAGE(PG8_SA(0, 0), cA, voffA); PG8_STAGE(PG8_SA(0, 1), cA + hstepA, voffA);
    if (wr == 1) PG8_BAR;
    PG8_WAIT_V(2); PG8_BAR;
    PG8_STAGE(PG8_SB(1, 0), cB + kstep, voffB); PG8_STAGE(PG8_SA(1, 0), cA + kstep, voffA); PG8_STAGE(PG8_SB(1, 1), cB + hstepB + kstep, voffB);
    PG8_WAIT_V(6); PG8_BAR;
    for (;;) {
        const bool has_next = S.next(ui + 1, nxt);
        const char* nA = has_next ? (const char*)g.A + (size_t)nxt.pm * tstepA + (size_t)nxt.ko * 2 : cA; const char* nB = has_next ? (const char*)g.Bt + (size_t)nxt.pn * tstepB + (size_t)nxt.ko * 2 + nxt.bofs : cB;
#define PG8_ITER(t, ZF) do { \
            const bool last = ((t) == nt - 2); \
            const char* a1 = cA + PG8_KOFFA((t) + 1); \
            const char* a2 = last ? nA : cA + PG8_KOFFA((t) + 2); const char* b2 = last ? nB : cB + (size_t)((t) + 2) * kstep; \
            const char* a3 = a2 + kstep; const char* b3 = b2 + kstep; \
            PG8_LDB(B0, 0, 0); PG8_LDB(B1, 0, 1); PG8_SCHED; PG8_LDA(At, 0, 0); PG8_STAGE(PG8_SA(1, 1), a1 + hstepA, voffA); \
            PG8_WAIT_V(8); PG8_WAIT_L(0); PG8_BAR; if constexpr (ZF) { PG8_MMA_Z(0, 0, At, B0); PG8_MMA_Z(0, 1, At, B1); } else { PG8_MMA(0, 0, At, B0); PG8_MMA(0, 1, At, B1); } PG8_BAR; PG8_SCHED; \
            PG8_LDA(At, 0, 1); PG8_STAGE(PG8_SB(0, 0), b2, voffB); PG8_STAGE(PG8_SB(0, 1), b2 + hstepB, voffB); PG8_STAGE(PG8_SA(0, 0), a2, voffA); \
            PG8_WAIT_V(8); PG8_WAIT_L(0); PG8_BAR; if constexpr (ZF) { PG8_MMA_Z(1, 0, At, B0); PG8_MMA_Z(1, 1, At, B1); } else { PG8_MMA(1, 0, At, B0); PG8_MMA(1, 1, At, B1); } PG8_BAR; PG8_SCHED; \
            PG8_LDB(B0, 1, 0); PG8_LDB(B1, 1, 1); PG8_SCHED; PG8_LDA(At, 1, 0); PG8_STAGE(PG8_SA(0, 1), a2 + hstepA, voffA); \
            PG8_WAIT_V(8); PG8_WAIT_L(0); PG8_BAR; PG8_MMA(0, 0, At, B0); PG8_MMA(0, 1, At, B1); PG8_BAR; PG8_SCHED; \
            PG8_LDA(At, 1, 1); PG8_STAGE(PG8_SB(1, 0), b3, voffB); PG8_STAGE(PG8_SB(1, 1), b3 + hstepB, voffB); PG8_STAGE(PG8_SA(1, 0), a3, voffA); \
            PG8_WAIT_V(8); PG8_WAIT_L(0); PG8_BAR; PG8_MMA(1, 0, At, B0); PG8_MMA(1, 1, At, B1); PG8_BAR; PG8_SCHED; \
        } while (0)
        int t = 0;
        if constexpr (ZEROC) { PG8_ITER(0, true); t = 2; }
#pragma unroll 1
        for (; t < nt; t += 2) PG8_ITER(t, false);
        if constexpr (ALIGN_EPI) { if (wr == 0) PG8_BAR; }
        if constexpr (F8) asm volatile("s_nop 15\n\ts_nop 7" ::: "memory");
        { int fr_e = fr, fq_e = fq; asm volatile("" : "+v"(fr_e), "+v"(fq_e));
          E(acc, cur, wr, wc, fr_e, fq_e); }
        if (!has_next) break;
        if (!ZEROC && !cur.keep) {
#pragma unroll
            for (int a = 0; a < 2; ++a)
#pragma unroll
                for (int b = 0; b < 2; ++b)
#pragma unroll
                    for (int m = 0; m < 4; ++m)
#pragma unroll
                        for (int n = 0; n < 2; ++n) acc[a][b][m][n] = (f32x4){0.f, 0.f, 0.f, 0.f};
        }
        cur = nxt; cA = nA; cB = nB; ++ui;
        if constexpr (ALIGN_EPI) { if (wr == 1) PG8_BAR; }
    }
    PG8_WAIT_V(0);
    if constexpr (!ALIGN_EPI) { if (wr == 0) PG8_BAR; }
    PG8_BAR;
#undef PG8_SA
#undef PG8_SB
#undef PG8_STAGE
#undef PG8_LDA
#undef PG8_LDB
#undef PG8_MMA
#undef PG8_MMA_Z
#undef PG8_KOFFA
#undef PG8_ITER
#undef PG8_CAT
#undef PG8_WAIT_V
#undef PG8_WAIT_L
#undef PG8_BAR
#undef PG8_SCHED
}
}
#include <hip/hip_bf16.h>
#include <cmath>
namespace attn_body {
using bf16=__hip_bfloat16;
using bf16x8=__attribute__((ext_vector_type(8)))short;
using s16x4=__attribute__((ext_vector_type(4)))short;
using f32x16=__attribute__((ext_vector_type(16)))float;
using u32x4=__attribute__((ext_vector_type(4)))unsigned;
constexpr int SEQ=8192,D=64,QP=512,KP=128,OP=1024,NKEYS=8448;
constexpr int NW=8,QBLK=32,QB=QBLK*NW,KVBLK=64,NQB=SEQ/QB;
constexpr int ATTN_UNIT_ROWS=QB;
__device__ __forceinline__ int crow(int r,int hi){return (r&3)+8*(r>>2)+4*hi;}
#define SBAR() __builtin_amdgcn_sched_barrier(0)
__device__ __forceinline__ void cmask(f32x16&p0,f32x16&p1,int jb,int qrel,int hi){
  const float NEG=-INFINITY; int kb=64*jb+4*hi;
  #pragma unroll
  for(int r=0;r<16;++r){int kv=kb+(r&3)+8*(r>>2); if(kv>qrel)p0[r]=NEG; if(kv+32>qrel)p1[r]=NEG;}
}

constexpr int NSLOT=3, SLOTB=8192;
constexpr int LDS_K=0, LDS_V=NSLOT*SLOTB, LDS_WS=2*NSLOT*SLOTB, LDS_OST=LDS_WS+NW*64*4, LDS_BYTES=LDS_OST+NW*4096;
constexpr float C2=0.125f*1.4426950408889634f;
__device__ __forceinline__ void glds16(const void*gsrc,unsigned lds_dst){unsigned keep;
  asm volatile("s_mov_b32 %0, m0\n\ts_mov_b32 m0, %2\n\ts_nop 0\n\tglobal_load_lds_dwordx4 %1, off\n\ts_mov_b32 m0, %0":"=&s"(keep):"v"(gsrc),"s"(lds_dst):"memory");}
__device__ __forceinline__ float max3f(float a,float b,float c){float r;asm("v_max3_f32 %0, %1, %2, %3":"=v"(r):"v"(a),"v"(b),"v"(c));return r;}
__device__ __forceinline__ float max2f(float a,float b){float r;asm("v_max_f32_e32 %0, %1, %2":"=v"(r):"v"(a),"v"(b));return r;}
__device__ __forceinline__ float fadd_s(float a,float b){float r;asm("v_add_f32_e32 %0, %1, %2":"=v"(r):"v"(a),"v"(b));return r;}
__device__ __forceinline__ float fsub_s(float a,float b){float r;asm("v_sub_f32_e32 %0, %1, %2":"=v"(r):"v"(a),"v"(b));return r;}
typedef float f32x2_t __attribute__((ext_vector_type(2))); typedef __bf16 bf16x2_t __attribute__((ext_vector_type(2)));
__device__ __forceinline__ unsigned cvtpk_s(float lo,float hi){f32x2_t v={lo,hi};bf16x2_t b=__builtin_convertvector(v,bf16x2_t);return __builtin_bit_cast(unsigned,b);}
#define WAIT_BAR(N) asm volatile("s_waitcnt vmcnt(" #N ") lgkmcnt(0)\n\ts_barrier":::"memory")

__device__ __forceinline__ void qkt(f32x16&p0,f32x16&p1,const char*Kslot,const bf16x8*qr,const f32x16&negm,int r32,int hi){
  const char*kb=Kslot+hi*1024+r32*16;
  #pragma unroll
  for(int d0=0;d0<4;++d0){
    const bf16x8 b0=*reinterpret_cast<const bf16x8*>(kb+d0*2048);
    const bf16x8 b1=*reinterpret_cast<const bf16x8*>(kb+d0*2048+512);
    if(d0==0){p0=__builtin_amdgcn_mfma_f32_32x32x16_bf16(b0,qr[0],negm,0,0,0);p1=__builtin_amdgcn_mfma_f32_32x32x16_bf16(b1,qr[0],negm,0,0,0);}
    else{p0=__builtin_amdgcn_mfma_f32_32x32x16_bf16(b0,qr[d0],p0,0,0,0);p1=__builtin_amdgcn_mfma_f32_32x32x16_bf16(b1,qr[d0],p1,0,0,0);}}
}
typedef __attribute__((address_space(3))) const char* lds_cptr;
typedef short v4i16_t __attribute__((ext_vector_type(4)));
__device__ __forceinline__ void kload8(bf16x8*kf,lds_cptr kp){
  kf[0]=*(const __attribute__((address_space(3))) bf16x8*)(kp);      kf[1]=*(const __attribute__((address_space(3))) bf16x8*)(kp+512);
  kf[2]=*(const __attribute__((address_space(3))) bf16x8*)(kp+2048); kf[3]=*(const __attribute__((address_space(3))) bf16x8*)(kp+2560);
  kf[4]=*(const __attribute__((address_space(3))) bf16x8*)(kp+4096); kf[5]=*(const __attribute__((address_space(3))) bf16x8*)(kp+4608);
  kf[6]=*(const __attribute__((address_space(3))) bf16x8*)(kp+6144); kf[7]=*(const __attribute__((address_space(3))) bf16x8*)(kp+6656);
}
__device__ __forceinline__ void kload2(bf16x8*kf,lds_cptr kp,int j){ kf[2*j]=*(const __attribute__((address_space(3))) bf16x8*)(kp+j*2048); kf[2*j+1]=*(const __attribute__((address_space(3))) bf16x8*)(kp+j*2048+512); }
__device__ __forceinline__ s16x4 vtr(lds_cptr p){ return __builtin_bit_cast(s16x4,__builtin_amdgcn_ds_read_tr16_b64_v4i16((__attribute__((address_space(3))) v4i16_t*)p)); }
__device__ __forceinline__ float rowmax(const f32x16&p0,const f32x16&p1){
  float a=max3f(p0[0],p0[1],p1[0]),b=max3f(p0[2],p0[3],p1[1]);a=max3f(a,p1[2],p1[3]);
  #pragma unroll
  for(int r=4;r<16;r+=4){a=max3f(a,p0[r],p0[r+1]);b=max3f(b,p0[r+2],p0[r+3]);a=max3f(a,p1[r],p1[r+1]);b=max3f(b,p1[r+2],p1[r+3]);}
  const float m=max2f(a,b);
  auto rr=__builtin_amdgcn_permlane32_swap(__float_as_uint(m),__float_as_uint(m),false,false);
  return max2f(__uint_as_float(rr[0]),__uint_as_float(rr[1]));
}
__device__ __forceinline__ void pv(f32x16*o,int vb,bf16x8 pa0,bf16x8 pa1,bf16x8 pa2,bf16x8 pa3){
  #pragma unroll
  for(int d0=0;d0<2;++d0){s16x4 lo[4],hi[4];
    #pragma unroll
    for(int ks=0;ks<4;++ks){
      asm volatile("ds_read_b64_tr_b16 %0,%1 offset:%c2":"=&v"(lo[ks]):"v"(vb),"i"(d0*4096+ks*1024):"memory");
      asm volatile("ds_read_b64_tr_b16 %0,%1 offset:%c2":"=&v"(hi[ks]):"v"(vb),"i"(d0*4096+ks*1024+512):"memory");}
    asm volatile("s_waitcnt lgkmcnt(0)":::"memory");SBAR();
    #define PK(k) (bf16x8){lo[k][0],lo[k][1],lo[k][2],lo[k][3],hi[k][0],hi[k][1],hi[k][2],hi[k][3]}
    o[d0]=__builtin_amdgcn_mfma_f32_32x32x16_bf16(pa0,PK(0),o[d0],0,0,0);
    o[d0]=__builtin_amdgcn_mfma_f32_32x32x16_bf16(pa1,PK(1),o[d0],0,0,0);
    o[d0]=__builtin_amdgcn_mfma_f32_32x32x16_bf16(pa2,PK(2),o[d0],0,0,0);
    o[d0]=__builtin_amdgcn_mfma_f32_32x32x16_bf16(pa3,PK(3),o[d0],0,0,0);
    #undef PK
  }
}

#ifndef ATTN_STORE16
#define ATTN_STORE16(p,v) (*(u32x4*)(p)=(v))
#endif
template<int THRL,bool NOREF,int ABL=0> __device__ __forceinline__ void attn_unit(int b,int h,int qb,const bf16*Q,const bf16*__restrict__ K,const bf16*__restrict__ V,bf16*O,char*shm){
  int tid_=threadIdx.x; asm volatile("":"+v"(tid_)); const int tid=tid_,lane=tid&63,r32=lane&31,hi=lane>>5; const int wid=__builtin_amdgcn_readfirstlane(tid>>6);
  const long rowbase=(long)b*SEQ; const int q0=qb*QB;
  const bf16*Qw=Q+(rowbase+q0+wid*QBLK)*QP+h*D;
  const bf16*Kh=K+(long)b*NKEYS*KP+(h>>2)*D,*Vh=V+(long)b*NKEYS*KP+(h>>2)*D;
  const unsigned lds0=(unsigned)(uintptr_t)shm;
  float*wsf=(float*)(shm+LDS_WS)+wid*64;
  const bf16*ksrc=Kh+(long)lane*KP+wid*8;
  const bf16*vsrc=Vh+(long)(16*(wid&3)+(lane>>2))*KP+(wid>>2)*32+(lane&3)*8;
  const unsigned kdst=lds0+LDS_K+wid*1024, vdst=lds0+LDS_V+wid*1024;
  #define DMA_K(t,slot) glds16(ksrc+(long)(t)*KVBLK*KP,(unsigned)__builtin_amdgcn_readfirstlane(kdst+(slot)))
  #define DMA_V(t,slot) glds16(vsrc+(long)(t)*KVBLK*KP,(unsigned)__builtin_amdgcn_readfirstlane(vdst+(slot)))
  const int vb0=(int)(lds0+LDS_V)+((lane>>4)&1)*32+(lane&3)*8+(4*hi+((lane&15)>>2))*64;
  const char*Kbase=shm+LDS_K; bf16x8 kf[8];
  const lds_cptr shm3=(lds_cptr)shm; const lds_cptr kp0=shm3+LDS_K+hi*1024+r32*16; const lds_cptr vp0=shm3+LDS_V+((lane>>4)&1)*32+(lane&3)*8+(4*hi+((lane&15)>>2))*64;
  constexpr int NT=NKEYS/KVBLK;
  DMA_K(0,0);DMA_V(0,0);DMA_K(1,SLOTB);
  bf16x8 qr[4];
  #pragma unroll
  for(int d0=0;d0<4;++d0)qr[d0]=*reinterpret_cast<const bf16x8*>(&Qw[(long)r32*QP+d0*16+hi*8]);
  float mhat=0.f,l_reg=0.f;f32x16 o[2];o[0]=f32x16{};o[1]=f32x16{};f32x16 negm=f32x16{};asm volatile("":"+v"(negm));
  #define CMASK(P0,P1,t) do{}while(0)
  bool resc=false;
  #define START(P0,P1) do{ if constexpr(!NOREF){ const float rm=rowmax(P0,P1); resc=false; \
    { const float dl=rm; mhat=fadd_s(mhat,dl); \
      _Pragma("unroll") for(int r=0;r<16;++r){P0[r]=fsub_s(P0[r],dl);P1[r]=fsub_s(P1[r],dl);} \
      _Pragma("unroll") for(int r=0;r<16;++r)negm[r]=-mhat; asm volatile("":"+v"(negm)); } } \
    _Pragma("unroll") for(int r=0;r<16;++r)P0[r]=__builtin_amdgcn_exp2f(P0[r]); }while(0)
  #define RESC() do{ if constexpr(!NOREF) if(resc){ asm volatile("s_waitcnt lgkmcnt(0)":::"memory"); \
      _Pragma("unroll") for(int d_=0;d_<2;++d_) _Pragma("unroll") for(int r=0;r<16;++r)o[d_][r]*=wsf[crow(r,hi)]; } }while(0)
  f32x16 pA0,pA1,pB0,pB1;
  int sl_prev=0,sl_cur=0,sl_next=SLOTB;
  #define ROT() do{sl_prev=sl_cur;sl_cur=sl_next;sl_next=(sl_next==(NSLOT-1)*SLOTB)?0:sl_next+SLOTB;}while(0)
  DMA_K(2,2*SLOTB);
  WAIT_BAR(3);
  qkt(pA0,pA1,Kbase,qr,negm,r32,hi);asm volatile("s_nop 15\n\ts_nop 7":"+v"(pA0),"+v"(pA1));CMASK(pA0,pA1,0);
  START(pA0,pA1);
  _Pragma("unroll") for(int r=0;r<16;++r)pA1[r]=__builtin_amdgcn_exp2f(pA1[r]);
  WAIT_BAR(0);
  DMA_K(3,0);DMA_V(1,SLOTB);
  ROT();
  kload8(kf,kp0+sl_cur);
  WAIT_BAR(2);
  s16x4 vlo[8],vhi[8]; u32x4 pw0,pw1,pw2,pw3;
  #define PKW(P,B) cvtpk_s(P[B],P[B+1])
  #define PAF(k) __builtin_bit_cast(bf16x8,pw##k)
  #define VFR(i) (bf16x8){vlo[i][0],vlo[i][1],vlo[i][2],vlo[i][3],vhi[i][0],vhi[i][1],vhi[i][2],vhi[i][3]}
  #define PIN(x) asm volatile("":"+v"(x))
  #define MX3(a,b,c) __builtin_fmaxf(__builtin_fmaxf((a),(b)),(c))
  #define GAPA(MF,A0,A1,A2,A3,W0,W1,PW) do{ MF; if constexpr(ABL!=2){ sacc+=A0; sacc+=A1; sacc+=A2; sacc+=A3; PIN(sacc); W0; W1; PIN(PW); } SBAR(); }while(0)
  #define EX(v) (ABL==1?(v):__builtin_amdgcn_exp2f(v))
  #define GAPB(MF,X,B) do{ MF; X[B]=EX(X[B]); X[B+1]=EX(X[B+1]); X[B+2]=EX(X[B+2]); X[B+3]=EX(X[B+3]); PIN(X); SBAR(); }while(0)
  #define VRD(i) do{ if constexpr(ABL!=3){ vlo[i]=vtr(vp_+(((i)>>2)*4096+((i)&3)*1024)); vhi[i]=vtr(vp_+(((i)>>2)*4096+((i)&3)*1024+512)); } }while(0)
  #define KRD(G,j) do{ if constexpr(ABL!=4){ if(G){ kload2(kf,kp0+sl_next,j); SBAR(); } } }while(0)
  #define AMFMA(a,b,c,x,y,z) (ABL==6?(c):__builtin_amdgcn_mfma_f32_32x32x16_bf16(a,b,c,x,y,z))
  #define STEP(C0,C1,P0,P1,t,GK,GV,GL) do{ SBAR(); \
    const lds_cptr vp_=vp0+sl_prev; \
    VRD(0); SBAR(); float sacc=(P0[0]+P0[1]); \
    GAPA(C0=AMFMA(kf[0],qr[0],negm,0,0,0), P0[2],P0[3],P0[4],P0[5],     pw0[0]=PKW(P0,0), pw0[1]=PKW(P0,2), pw0); \
    VRD(4); SBAR(); GAPA(C1=AMFMA(kf[1],qr[0],negm,0,0,0), P0[6],P0[7],P0[8],P0[9],     pw0[2]=PKW(P0,4), pw0[3]=PKW(P0,6), pw0); \
    VRD(1); SBAR(); GAPA(C0=AMFMA(kf[2],qr[1],C0,0,0,0),   P0[10],P0[11],P0[12],P0[13], pw1[0]=PKW(P0,8), pw1[1]=PKW(P0,10), pw1); \
    VRD(5); SBAR(); GAPA(C1=AMFMA(kf[3],qr[1],C1,0,0,0),   P0[14],P0[15],P1[0],P1[1],   pw1[2]=PKW(P0,12),pw1[3]=PKW(P0,14), pw1); \
    VRD(2); SBAR(); GAPA(C0=AMFMA(kf[4],qr[2],C0,0,0,0),   P1[2],P1[3],P1[4],P1[5],     pw2[0]=PKW(P1,0), pw2[1]=PKW(P1,2), pw2); \
    VRD(6); SBAR(); GAPA(C1=AMFMA(kf[5],qr[2],C1,0,0,0),   P1[6],P1[7],P1[8],P1[9],     pw2[2]=PKW(P1,4), pw2[3]=PKW(P1,6), pw2); \
    VRD(3); SBAR(); GAPA(C0=AMFMA(kf[6],qr[3],C0,0,0,0),   P1[10],P1[11],P1[12],P1[13], pw3[0]=PKW(P1,8), pw3[1]=PKW(P1,10), pw3); \
    VRD(7); SBAR(); GAPA(C1=AMFMA(kf[7],qr[3],C1,0,0,0),   P1[14],P1[15],0.f,0.f,       pw3[2]=PKW(P1,12),pw3[3]=PKW(P1,14), pw3); \
    l_reg+=sacc; \
    if constexpr(ABL!=7){ if(GK){DMA_K((t)+3,sl_cur);} if(GV){DMA_V((t)+1,sl_next);} } \
    CMASK(C0,C1,t); \
    if constexpr(!NOREF){ float a=MX3(C0[0],C0[1],C1[0]),b=MX3(C0[2],C0[3],C1[1]); a=MX3(a,C1[2],C1[3]); \
      _Pragma("unroll") for(int r=4;r<16;r+=4){a=MX3(a,C0[r],C0[r+1]);b=MX3(b,C0[r+2],C0[r+3]);a=MX3(a,C1[r],C1[r+1]);b=MX3(b,C1[r+2],C1[r+3]);} \
      float rm=__builtin_fmaxf(a,b); { auto rr=__builtin_amdgcn_permlane32_swap(__float_as_uint(rm),__float_as_uint(rm),false,false); rm=__builtin_fmaxf(__uint_as_float(rr[0]),__uint_as_float(rr[1])); } \
      resc=false; \
      if(__builtin_expect(__any(rm>(float)THRL),0)){ const float dl=__builtin_fmaxf(rm,0.f); mhat+=dl; \
        _Pragma("unroll") for(int r=0;r<16;++r){C0[r]-=dl;C1[r]-=dl;} \
        _Pragma("unroll") for(int r=0;r<16;++r)negm[r]=-mhat; asm volatile("":"+v"(negm)); \
        const float f=__builtin_amdgcn_exp2f(-dl); l_reg*=f; if(hi==0)wsf[r32]=f; resc=true; } } \
    SBAR(); \
    GAPB(o[0]=AMFMA(PAF(0),VFR(0),o[0],0,0,0), C0,0); \
    GAPB(o[1]=AMFMA(PAF(0),VFR(4),o[1],0,0,0), C0,4); \
    KRD(GL,0); GAPB(o[0]=AMFMA(PAF(1),VFR(1),o[0],0,0,0), C0,8); \
    KRD(GL,1); GAPB(o[1]=AMFMA(PAF(1),VFR(5),o[1],0,0,0), C0,12); \
    KRD(GL,2); GAPB(o[0]=AMFMA(PAF(2),VFR(2),o[0],0,0,0), C1,0); \
    KRD(GL,3); GAPB(o[1]=AMFMA(PAF(2),VFR(6),o[1],0,0,0), C1,4); \
    GAPB(o[0]=AMFMA(PAF(3),VFR(3),o[0],0,0,0), C1,8); \
    GAPB(o[1]=AMFMA(PAF(3),VFR(7),o[1],0,0,0), C1,12); \
    }while(0)
  int t=1;
  #undef CMASK
  #define CMASK(P0,P1,t) do{}while(0)
  for(;t+5<NT;t+=2){
    STEP(pB0,pB1,pA0,pA1,t,true,true,true);     if constexpr(ABL==5){asm volatile("s_waitcnt vmcnt(2) lgkmcnt(0)":::"memory");}else{WAIT_BAR(2);} RESC(); ROT();
    STEP(pA0,pA1,pB0,pB1,t+1,true,true,true);   if constexpr(ABL==5){asm volatile("s_waitcnt vmcnt(2) lgkmcnt(0)":::"memory");}else{WAIT_BAR(2);} RESC(); ROT();
  }
  #undef CMASK
  #define CMASK(P0,P1,t) do{}while(0)
  #define ENDW(tt) do{ if((tt)+3<NT){WAIT_BAR(2);} else if((tt)+2<NT){WAIT_BAR(1);} else {WAIT_BAR(0);} }while(0)
  for(;t+1<NT;t+=2){
    STEP(pB0,pB1,pA0,pA1,t,(t+3<NT),(t+1<NT),(t+1<NT));       ENDW(t);   RESC(); ROT();
    STEP(pA0,pA1,pB0,pB1,t+1,(t+4<NT),(t+2<NT),(t+2<NT));     ENDW(t+1); RESC(); ROT();
  }
  STEP(pB0,pB1,pA0,pA1,NT-1,false,false,false); RESC();
  { float sacc=pB0[0]+pB0[1]; _Pragma("unroll") for(int r=2;r<16;++r)sacc+=pB0[r]; _Pragma("unroll") for(int r=0;r<16;++r)sacc+=pB1[r]; l_reg+=sacc;
    pw0=(u32x4){PKW(pB0,0),PKW(pB0,2),PKW(pB0,4),PKW(pB0,6)};pw1=(u32x4){PKW(pB0,8),PKW(pB0,10),PKW(pB0,12),PKW(pB0,14)};pw2=(u32x4){PKW(pB1,0),PKW(pB1,2),PKW(pB1,4),PKW(pB1,6)};pw3=(u32x4){PKW(pB1,8),PKW(pB1,10),PKW(pB1,12),PKW(pB1,14)};
    SBAR(); pv(o,vb0+sl_cur,PAF(0),PAF(1),PAF(2),PAF(3)); }
  #undef PKW
  #undef PAF
  #undef VFR
  #undef PIN
  #undef MX3
  #undef GAPA
  #undef GAPB
  #undef EX
  #undef VRD
  #undef KRD
  #undef STEP
  #undef ENDW
  {auto rr=__builtin_amdgcn_permlane32_swap(__float_as_uint(l_reg),__float_as_uint(l_reg),false,false);l_reg=__uint_as_float(rr[0])+__uint_as_float(rr[1]);}
  if(hi==0)wsf[32+r32]=l_reg;asm volatile("s_waitcnt lgkmcnt(0)":::"memory");
  float rli[16];
  #pragma unroll
  for(int r=0;r<16;++r)rli[r]=__builtin_amdgcn_rcpf(wsf[32+crow(r,hi)]);
  bf16*Ow=O+(rowbase+q0+wid*QBLK)*OP+h*D;
  { bf16*stg=(bf16*)(shm+LDS_OST)+wid*2048;
    #pragma unroll
    for(int r=0;r<16;++r){const int orow=crow(r,hi);
      #pragma unroll
      for(int d0=0;d0<2;++d0)stg[orow*64+d0*32+r32]=__float2bfloat16(o[d0][r]*rli[r]);}
    asm volatile("s_waitcnt lgkmcnt(0)":::"memory");
    #pragma unroll
    for(int i=0;i<4;++i){const int row=i*8+(lane>>3),ch=lane&7; const u32x4 v=*(const u32x4*)(stg+row*64+ch*8); ATTN_STORE16(Ow+(long)row*OP+ch*8,v);} }
  asm volatile("s_waitcnt lgkmcnt(0)\n\ts_barrier":::"memory");
  #undef DMA_K
  #undef DMA_V
  #undef CMASK
  #undef START
  #undef RESC
  #undef ROT
}

constexpr int A64_K=0, A64_V=65536, A64_WS=98304, LDS_BYTES64=A64_WS+NW*64*4;
typedef int v8i_t __attribute__((ext_vector_type(8)));
__device__ __forceinline__ void attn_unit64f8(int b,int h,int qb,const unsigned char*Q8,const unsigned char*K8,const bf16*__restrict__ V,bf16*O,char*shm){
  int tid_=threadIdx.x; asm volatile("":"+v"(tid_)); const int tid=tid_,lane=tid&63,r32=lane&31,hi=lane>>5; const int wid=__builtin_amdgcn_readfirstlane(tid>>6);
  const long rowbase=(long)b*SEQ; const int q0=qb*(2*QB);
  const unsigned char*Qw8=Q8+(rowbase+q0+wid*64)*512+h*64;
  const unsigned char*Kh8=K8+(long)b*NKEYS*128+(h>>2)*64; const bf16*Vh=V+(long)b*NKEYS*KP+(h>>2)*D;
  const unsigned lds0=(unsigned)(uintptr_t)shm;
  const unsigned char*ksrc=Kh8+(long)lane*128+(wid&3)*16;
  const bf16*vsrc=Vh+(long)(16*(wid&3)+(lane>>2))*KP+(wid>>2)*32+(lane&3)*8;
  const unsigned kdst=lds0+A64_K+(wid&3)*1024, vdst=lds0+A64_V+wid*1024;
  #define DMA_KP(p,slot) glds16((p),(unsigned)__builtin_amdgcn_readfirstlane(kdst+(slot)))
  #define DMA_VP(p,slot) glds16((p),(unsigned)__builtin_amdgcn_readfirstlane(vdst+(slot)))
  const lds_cptr shm3=(lds_cptr)shm; const lds_cptr kp0=shm3+A64_K+(2*hi)*1024+r32*16; const lds_cptr vp0=shm3+A64_V+((lane>>4)&1)*32+(lane&3)*8+(4*hi+((lane&15)>>2))*64;
  constexpr int NT=NKEYS/KVBLK; static_assert(NT>=8,"peeled head and tail");
  constexpr long TSTEP=(long)KVBLK*KP, TSTEP8=(long)KVBLK*128;
  DMA_KP(ksrc,0);DMA_VP(vsrc,0);DMA_KP(ksrc+TSTEP8,SLOTB);
  v8i_t qr0,qr1;
  { const u32x4 a0=*(const u32x4*)(Qw8+(long)r32*512+32*hi), a1=*(const u32x4*)(Qw8+(long)r32*512+32*hi+16), b0=*(const u32x4*)(Qw8+(long)(32+r32)*512+32*hi), b1=*(const u32x4*)(Qw8+(long)(32+r32)*512+32*hi+16);
    qr0=(v8i_t){(int)a0.x,(int)a0.y,(int)a0.z,(int)a0.w,(int)a1.x,(int)a1.y,(int)a1.z,(int)a1.w}; qr1=(v8i_t){(int)b0.x,(int)b0.y,(int)b0.z,(int)b0.w,(int)b1.x,(int)b1.y,(int)b1.z,(int)b1.w}; }
  DMA_KP(ksrc+2*TSTEP8,2*SLOTB);DMA_VP(vsrc+TSTEP,SLOTB);
  const unsigned char*kq=ksrc+3*TSTEP8; const bf16*vq=vsrc+2*TSTEP;
  f32x16 o0[2],o1[2]; o0[0]=f32x16{};o0[1]=f32x16{};o1[0]=f32x16{};o1[1]=f32x16{};
  typedef float f32x4_t __attribute__((ext_vector_type(4))); f32x4_t lacc0={0.f,0.f,0.f,0.f},lacc1={0.f,0.f,0.f,0.f};
  bf16x8 sel; { const short one=((lane&15)==((lane>>4)&1))?(short)0x3F80:(short)0; sel=(bf16x8){one,one,one,one,one,one,one,one}; asm volatile("":"+v"(sel)); }
  v8i_t kfA,kfB; f32x16 S0a,S0b,S1a,S1b;
  #define KR8(dst,kp) do{ const u32x4 x0_=*(const __attribute__((address_space(3))) u32x4*)(kp), x1_=*(const __attribute__((address_space(3))) u32x4*)((kp)+1024); \
    dst=(v8i_t){(int)x0_.x,(int)x0_.y,(int)x0_.z,(int)x0_.w,(int)x1_.x,(int)x1_.y,(int)x1_.z,(int)x1_.w}; }while(0)
  WAIT_BAR(2);
  KR8(kfA,kp0);
  #define MF(a,b,c) __builtin_amdgcn_mfma_f32_32x32x16_bf16(a,b,c,0,0,0)
  #define MF8(a,b) __builtin_amdgcn_mfma_scale_f32_32x32x64_f8f6f4(a,b,ZZ,0,0,0,0,0,0)
  #define MFS(PF,LA) LA=__builtin_amdgcn_mfma_f32_16x16x32_bf16(sel,PF,LA,0,0,0)
  #define PIN(x) asm volatile("":"+v"(x))
  #define E2(X,p) do{ X[2*(p)]=__builtin_amdgcn_exp2f(X[2*(p)]); X[2*(p)+1]=__builtin_amdgcn_exp2f(X[2*(p)+1]); PIN(X); }while(0)
  #define P1(X,p) do{ X[((p)&4)*2+((p)&3)]=__uint_as_float(cvtpk_s(X[2*(p)],X[2*(p)+1])); PIN(X); }while(0)
  #define PLO(X) __builtin_bit_cast(bf16x8,__builtin_shufflevector(X,X,0,1,2,3))
  #define PHI(X) __builtin_bit_cast(bf16x8,__builtin_shufflevector(X,X,8,9,10,11))
  #define VFR(i) (bf16x8){vlo[i][0],vlo[i][1],vlo[i][2],vlo[i][3],vhi[i][0],vhi[i][1],vhi[i][2],vhi[i][3]}
  #define VRDP(vp,i) do{ vlo[i]=vtr((vp)+(((i)>>2)*4096+((i)&3)*1024)); vhi[i]=vtr((vp)+(((i)>>2)*4096+((i)&3)*1024+512)); }while(0)
  #define SLOT(j) ((((j))&3)*SLOTB)
  #define VQ1(g) do{ if((g)==0){E2(S0b,4);P1(S1b,3);} if((g)==1){E2(S1b,4);P1(S0b,4);} if((g)==2){E2(S0b,5);P1(S1b,4);} if((g)==3){E2(S1b,5);P1(S0b,5);} \
                     if((g)==4){E2(S0b,6);P1(S1b,5);} if((g)==5){E2(S1b,6);P1(S0b,6);} if((g)==6){E2(S0b,7);P1(S1b,6);} if((g)==7){E2(S1b,7);P1(S0b,7);} }while(0)
  #define VQ2(g,FIRST) do{ if((g)==0){E2(S0a,0); if(!(FIRST)){P1(S1b,7);} } if((g)==1){E2(S1a,0);P1(S0a,0);} if((g)==2){E2(S0a,1);P1(S1a,0);} if((g)==3){E2(S1a,1);P1(S0a,1);} \
                     if((g)==4){E2(S0a,2);P1(S1a,1);} if((g)==5){E2(S1a,2);P1(S0a,2);} if((g)==6){E2(S0a,3);P1(S1a,2);} if((g)==7){E2(S1a,3);P1(S0a,3);} }while(0)
  #define VQ3(g) do{ if((g)==0){E2(S0a,4);P1(S1a,3);} if((g)==1){E2(S1a,4);P1(S0a,4);} if((g)==2){E2(S0a,5);P1(S1a,4);} if((g)==3){E2(S1a,5);P1(S0a,5);} \
                     if((g)==4){E2(S0a,6);P1(S1a,5);} if((g)==5){E2(S1a,6);P1(S0a,6);} if((g)==6){E2(S0a,7);P1(S1a,6);} if((g)==7){E2(S1a,7);P1(S0a,7);} }while(0)
  #define VQ4(g) do{ if((g)==0){E2(S0b,0);P1(S1a,7);} if((g)==1){E2(S1b,0);P1(S0b,0);} if((g)==2){E2(S0b,1);P1(S1b,0);} if((g)==3){E2(S1b,1);P1(S0b,1);} \
                     if((g)==4){E2(S0b,2);P1(S1b,1);} if((g)==5){E2(S1b,2);P1(S0b,2);} if((g)==6){E2(S0b,3);P1(S1b,2);} if((g)==7){E2(S1b,3);P1(S0b,3);} }while(0)
  #define SL(i,FIRST) do{ if((i)<8){ if(!(FIRST)){VQ1((i)&7);} } else if((i)<16){ VQ2((i)&7,FIRST); } else if((i)<24){ VQ3((i)&7); } else { VQ4((i)&7); } }while(0)
  #define STEPF(s,FIRST,GK,GV,GL) do{ s16x4 vlo[8],vhi[8]; const f32x16 ZZ=f32x16{}; \
    const lds_cptr vpp=vp0+SLOT((s)+3), vpc=vp0+SLOT(s), kpc=kp0+SLOT(s), kpn=kp0+SLOT((s)+1); \
    SBAR(); \
    S0a=MF8(kfA,qr0); SL(0,FIRST); SL(1,FIRST); SL(2,FIRST); if(!(FIRST)){VRDP(vpp,2); VRDP(vpp,6);} KR8(kfB,kpc+512); SBAR(); \
    if(GK){DMA_KP(kq,SLOT((s)+3));} if(GV){DMA_VP(vq,SLOT((s)+2));} kq+=TSTEP8; vq+=TSTEP; SBAR(); \
    S1a=MF8(kfA,qr1); SL(3,FIRST); SL(4,FIRST); SL(5,FIRST); if(!(FIRST)){VRDP(vpp,3); VRDP(vpp,7);} SBAR(); \
    if(!(FIRST)){o0[0]=MF(PLO(S0b),VFR(2),o0[0]); MFS(PLO(S0b),lacc0);} SL(6,FIRST); SL(7,FIRST); SBAR(); \
    if(!(FIRST)){o1[0]=MF(PLO(S1b),VFR(2),o1[0]); MFS(PLO(S1b),lacc1);} SL(8,FIRST); SL(9,FIRST); SBAR(); \
    if(!(FIRST)){o0[1]=MF(PLO(S0b),VFR(6),o0[1]);} SL(10,FIRST); SBAR(); \
    if(!(FIRST)){o1[1]=MF(PLO(S1b),VFR(6),o1[1]);} SL(11,FIRST); SBAR(); \
    if(!(FIRST)){o0[0]=MF(PHI(S0b),VFR(3),o0[0]); MFS(PHI(S0b),lacc0);} SL(12,FIRST); SBAR(); \
    if(!(FIRST)){o1[0]=MF(PHI(S1b),VFR(3),o1[0]); MFS(PHI(S1b),lacc1);} SL(13,FIRST); SBAR(); \
    if(!(FIRST)){o0[1]=MF(PHI(S0b),VFR(7),o0[1]);} SL(14,FIRST); SBAR(); \
    if(!(FIRST)){o1[1]=MF(PHI(S1b),VFR(7),o1[1]);} SL(15,FIRST); SBAR(); \
    S0b=MF8(kfB,qr0); SL(16,FIRST); SL(17,FIRST); SL(18,FIRST); VRDP(vpc,0); VRDP(vpc,4); if(GL){KR8(kfA,kpn);} SBAR(); \
    S1b=MF8(kfB,qr1); SL(19,FIRST); SL(20,FIRST); SL(21,FIRST); VRDP(vpc,1); VRDP(vpc,5); SBAR(); \
    o0[0]=MF(PLO(S0a),VFR(0),o0[0]); MFS(PLO(S0a),lacc0); SL(22,FIRST); SL(23,FIRST); SBAR(); \
    o1[0]=MF(PLO(S1a),VFR(0),o1[0]); MFS(PLO(S1a),lacc1); SL(24,FIRST); SL(25,FIRST); SBAR(); \
    o0[1]=MF(PLO(S0a),VFR(4),o0[1]); SL(26,FIRST); SBAR(); \
    o1[1]=MF(PLO(S1a),VFR(4),o1[1]); SL(27,FIRST); SBAR(); \
    o0[0]=MF(PHI(S0a),VFR(1),o0[0]); MFS(PHI(S0a),lacc0); SL(28,FIRST); SBAR(); \
    o1[0]=MF(PHI(S1a),VFR(1),o1[0]); MFS(PHI(S1a),lacc1); SL(29,FIRST); SBAR(); \
    o0[1]=MF(PHI(S0a),VFR(5),o0[1]); SL(30,FIRST); SBAR(); \
    o1[1]=MF(PHI(S1a),VFR(5),o1[1]); SL(31,FIRST); SBAR(); \
    }while(0)
  STEPF(0,true,true,true,true); WAIT_BAR(2);
  #pragma unroll 1
  for(int s=1;s<NT-3;++s){ STEPF(s,false,true,true,true); WAIT_BAR(2); }
  STEPF(NT-3,false,false,true,true);  WAIT_BAR(1);
  STEPF(NT-2,false,false,false,true); WAIT_BAR(0);
  STEPF(NT-1,false,false,false,false); WAIT_BAR(0);
  {
    s16x4 vlo[8],vhi[8]; const lds_cptr vpp=vp0+SLOT(NT-1);
    SBAR(); VRDP(vpp,2); VRDP(vpp,6); VRDP(vpp,3); VRDP(vpp,7); SBAR();
    VQ1(0);VQ1(1);VQ1(2);VQ1(3);VQ1(4);VQ1(5);VQ1(6);VQ1(7); P1(S1b,7); SBAR();
    o0[0]=MF(PLO(S0b),VFR(2),o0[0]); MFS(PLO(S0b),lacc0); o1[0]=MF(PLO(S1b),VFR(2),o1[0]); MFS(PLO(S1b),lacc1);
    o0[1]=MF(PLO(S0b),VFR(6),o0[1]); o1[1]=MF(PLO(S1b),VFR(6),o1[1]);
    o0[0]=MF(PHI(S0b),VFR(3),o0[0]); MFS(PHI(S0b),lacc0); o1[0]=MF(PHI(S1b),VFR(3),o1[0]); MFS(PHI(S1b),lacc1);
    o0[1]=MF(PHI(S0b),VFR(7),o0[1]); o1[1]=MF(PHI(S1b),VFR(7),o1[1]); SBAR(); }
  #undef MF
  #undef MF8
  #undef MFS
  #undef PIN
  #undef E2
  #undef P1
  #undef PLO
  #undef PHI
  #undef VFR
  #undef VRDP
  #undef KR8
  #undef SLOT
  #undef VQ1
  #undef VQ2
  #undef VQ3
  #undef VQ4
  #undef SL
  #undef STEPF
  #undef DMA_KP
  #undef DMA_VP
  asm volatile("s_waitcnt lgkmcnt(0)\n\ts_barrier":::"memory");
  { int le=lane; asm volatile("":"+v"(le)); const int r32e=le&31,hie=le>>5;
    float*wse=(float*)(shm+A64_WS)+wid*64;
    if(le<16){wse[le]=lacc0[0];wse[16+le]=lacc0[1];wse[32+le]=lacc1[0];wse[48+le]=lacc1[1];} asm volatile("s_waitcnt lgkmcnt(0)":::"memory");
    bf16*Ow=O+(rowbase+q0+wid*64)*OP+h*D;
    bf16*stg=(bf16*)(shm)+wid*4096;
    #pragma unroll
    for(int r=0;r<16;++r){const int orow=crow(r,hie); const float rl=__builtin_amdgcn_rcpf(wse[orow]);
      #pragma unroll
      for(int d0=0;d0<2;++d0)stg[orow*64+d0*32+r32e]=__float2bfloat16(o0[d0][r]*rl);}
    #pragma unroll
    for(int r=0;r<16;++r){const int orow=crow(r,hie); const float rl=__builtin_amdgcn_rcpf(wse[32+orow]);
      #pragma unroll
      for(int d0=0;d0<2;++d0)stg[(32+orow)*64+d0*32+r32e]=__float2bfloat16(o1[d0][r]*rl);}
    asm volatile("s_waitcnt lgkmcnt(0)":::"memory");
    #pragma unroll
    for(int i=0;i<8;++i){const int row=i*8+(le>>3),ch=le&7; const u32x4 v=*(const u32x4*)(stg+row*64+ch*8); ATTN_STORE16(Ow+(long)row*OP+ch*8,v);} }
  asm volatile("s_waitcnt lgkmcnt(0)\n\ts_barrier":::"memory");
}

__device__ __forceinline__ void attn_unit64ff(int b,int h,int qb,const unsigned char*Q8,const unsigned char*K8,const unsigned char*V8T,bf16*O,char*shm){
  int tid_=threadIdx.x; asm volatile("":"+v"(tid_)); const int tid=tid_,lane=tid&63,r32=lane&31,hi=lane>>5; const int wid=__builtin_amdgcn_readfirstlane(tid>>6);
  const long rowbase=(long)b*SEQ; const int q0=qb*(2*QB);
  const unsigned char*Qw8=Q8+(rowbase+q0+wid*64)*512+h*64;
  const unsigned char*Kh8=K8+(long)b*NKEYS*128+(h>>2)*64; const unsigned char*Vt8=V8T+(long)((b*2+(h>>2))*(NKEYS/KVBLK))*4096;
  const unsigned lds0=(unsigned)(uintptr_t)shm;
  const bool kw=wid<4; const int ch=wid&3;
  const unsigned char*dsrc=kw?Kh8+(long)lane*128+ch*16:Vt8+(long)lane*64+ch*16;
  const long dstep=kw?(long)KVBLK*128:4096;
  const unsigned ddst=lds0+(kw?A64_K:A64_V)+ch*1024;
  #define DMA1(p,slot) glds16((p),(unsigned)__builtin_amdgcn_readfirstlane(ddst+(slot)))
  const lds_cptr shm3=(lds_cptr)shm; const lds_cptr kp0=shm3+A64_K+(2*hi)*1024+r32*16; const lds_cptr vfp0=shm3+A64_V+(2*hi)*1024+r32*16;
  constexpr int NT=NKEYS/KVBLK; static_assert((NT-3)%3==0&&NT>=6,"steady loop runs three steps (one ring turn) per iteration, then three peeled steps");
  DMA1(dsrc,0); if(kw){DMA1(dsrc+dstep,SLOTB);}
  v8i_t qr0,qr1;
  { const u32x4 a0=*(const u32x4*)(Qw8+(long)r32*512+32*hi), a1=*(const u32x4*)(Qw8+(long)r32*512+32*hi+16), b0=*(const u32x4*)(Qw8+(long)(32+r32)*512+32*hi), b1=*(const u32x4*)(Qw8+(long)(32+r32)*512+32*hi+16);
    qr0=(v8i_t){(int)a0.x,(int)a0.y,(int)a0.z,(int)a0.w,(int)a1.x,(int)a1.y,(int)a1.z,(int)a1.w}; qr1=(v8i_t){(int)b0.x,(int)b0.y,(int)b0.z,(int)b0.w,(int)b1.x,(int)b1.y,(int)b1.z,(int)b1.w}; }
  if(kw){DMA1(dsrc+2*dstep,2*SLOTB);}else{DMA1(dsrc+dstep,SLOTB);}
  const unsigned char*dq=dsrc+(kw?3*dstep:2*dstep);
  f32x16 o0[2],o1[2]; o0[0]=f32x16{};o0[1]=f32x16{};o1[0]=f32x16{};o1[1]=f32x16{};
  typedef float f32x4_t __attribute__((ext_vector_type(4))); f32x4_t lacc0={0.f,0.f,0.f,0.f},lacc1={0.f,0.f,0.f,0.f};
  v8i_t sel8; { const int one=((lane&15)==((lane>>4)&1))?0x38383838:0; sel8=(v8i_t){one,one,one,one,one,one,one,one}; asm volatile("":"+v"(sel8)); }
  v8i_t kfA,kfB;
  #define KR8(dst,kp) do{ const u32x4 x0_=*(const __attribute__((address_space(3))) u32x4*)(kp), x1_=*(const __attribute__((address_space(3))) u32x4*)((kp)+1024); \
    dst=(v8i_t){(int)x0_.x,(int)x0_.y,(int)x0_.z,(int)x0_.w,(int)x1_.x,(int)x1_.y,(int)x1_.z,(int)x1_.w}; }while(0)
  WAIT_BAR(1);
  KR8(kfA,kp0); KR8(kfB,kp0+512);
  WAIT_BAR(1);
  #define MF8(a,b) __builtin_amdgcn_mfma_scale_f32_32x32x64_f8f6f4(a,b,ZZ,0,0,0,0,0,0)
  #define MF8P(pa,vb,c) __builtin_amdgcn_mfma_scale_f32_32x32x64_f8f6f4(pa,vb,c,1,0,0,0,0,0)
  #define MFSF(pa,LA) LA=__builtin_amdgcn_mfma_scale_f32_16x16x128_f8f6f4(sel8,pa,LA,0,1,0,0,0,0)
  #define PIN(x) asm volatile("":"+v"(x))
  #define E2(X,p) do{ X[2*(p)]=__builtin_amdgcn_exp2f(X[2*(p)]); X[2*(p)+1]=__builtin_amdgcn_exp2f(X[2*(p)+1]); }while(0)
  #define K2(X,p,T,WB) do{ T[(WB)+((p)>>1)]=__builtin_bit_cast(float,__builtin_amdgcn_cvt_pk_bf8_f32(X[2*(p)],X[2*(p)+1],__float_as_int(T[(WB)+((p)>>1)]),((p)&1)!=0)); }while(0)
  #define SL8(X,T,WB) do{ E2(X,0); E2(X,1); K2(X,0,T,WB); E2(X,2); K2(X,1,T,WB); E2(X,3); K2(X,2,T,WB); E2(X,4); K2(X,3,T,WB); E2(X,5); K2(X,4,T,WB); E2(X,6); K2(X,5,T,WB); E2(X,7); K2(X,6,T,WB); }while(0)
  #define P8(X) __builtin_bit_cast(v8i_t,__builtin_shufflevector(X,X,0,1,2,3,4,5,6,7))
  #define SL4A(X,T,WB) do{ E2(X,0); E2(X,1); K2(X,0,T,WB); E2(X,2); K2(X,1,T,WB); E2(X,3); K2(X,2,T,WB); PIN(X); PIN(T); }while(0)
  #define SL4B(X,T,WB) do{ E2(X,4); K2(X,3,T,WB); E2(X,5); K2(X,4,T,WB); E2(X,6); K2(X,5,T,WB); E2(X,7); K2(X,6,T,WB); PIN(X); PIN(T); }while(0)
  #define STEPX(C0a,C0b,C1a,C1b,N0a,N0b,N1a,N1b,FIRST,GD,LAST) do{ const f32x16 ZZ=f32x16{}; \
    SBAR(); \
    if(!(FIRST)){o0[0]=MF8P(P8(N0a),vf0,o0[0]); MFSF(P8(N0a),lacc0);} SL4A(C0a,C0a,0); SBAR(); \
    if(GD){ DMA1(dq,kw?sc:sp); } dq+=dstep; SBAR(); \
    if(!(FIRST)){o0[1]=MF8P(P8(N0a),vf1,o0[1]);} SL4B(C0a,C0a,0); if(!(LAST)){KR8(kfA,kp0+sn);} SBAR(); \
    if(!(FIRST)){o1[0]=MF8P(P8(N1a),vf0,o1[0]); MFSF(P8(N1a),lacc1);} K2(C0a,7,C0a,0); SL4A(C0b,C0a,4); if(!(LAST)){KR8(kfB,kp0+sn+512);} SBAR(); \
    if(!(FIRST)){o1[1]=MF8P(P8(N1a),vf1,o1[1]);} SL4B(C0b,C0a,4); SBAR(); \
    if(!(LAST)){N0a=MF8(kfA,qr0);} K2(C0b,7,C0a,4); SL4A(C1a,C1a,0); SBAR(); \
    if(!(LAST)){N0b=MF8(kfB,qr0);} SL4B(C1a,C1a,0); KR8(vf0,vfp0+sc); SBAR(); \
    if(!(LAST)){N1a=MF8(kfA,qr1);} K2(C1a,7,C1a,0); SL4A(C1b,C1a,4); KR8(vf1,vfp0+sc+512); SBAR(); \
    if(!(LAST)){N1b=MF8(kfB,qr1);} SL4B(C1b,C1a,4); K2(C1b,7,C1a,4); SBAR(); \
    { const int t_=sc; sc=sn; sn=sp; sp=t_; } \
    }while(0)
  f32x16 A0a,A0b,A1a,A1b,B0a,B0b,B1a,B1b; v8i_t vf0,vf1; int sc=0,sn=SLOTB,sp=2*SLOTB;
  { const f32x16 ZZ=f32x16{}; A0a=MF8(kfA,qr0); A0b=MF8(kfB,qr0); A1a=MF8(kfA,qr1); A1b=MF8(kfB,qr1); }
  STEPX(A0a,A0b,A1a,A1b,B0a,B0b,B1a,B1b,true,true,false);  WAIT_BAR(1);
  STEPX(B0a,B0b,B1a,B1b,A0a,A0b,A1a,A1b,false,true,false); WAIT_BAR(1);
  #pragma unroll 1
  for(int t=2;t<NT-4;t+=2){
    STEPX(A0a,A0b,A1a,A1b,B0a,B0b,B1a,B1b,false,true,false); WAIT_BAR(1);
    STEPX(B0a,B0b,B1a,B1b,A0a,A0b,A1a,A1b,false,true,false); WAIT_BAR(1);
  }
  STEPX(A0a,A0b,A1a,A1b,B0a,B0b,B1a,B1b,false,true,false);   WAIT_BAR(1);
  STEPX(B0a,B0b,B1a,B1b,A0a,A0b,A1a,A1b,false,(!kw),false);  WAIT_BAR(0);
  STEPX(A0a,A0b,A1a,A1b,B0a,B0b,B1a,B1b,false,false,false);  WAIT_BAR(0);
  STEPX(B0a,B0b,B1a,B1b,A0a,A0b,A1a,A1b,false,false,true);
  o0[0]=MF8P(P8(B0a),vf0,o0[0]); MFSF(P8(B0a),lacc0); o0[1]=MF8P(P8(B0a),vf1,o0[1]);
  o1[0]=MF8P(P8(B1a),vf0,o1[0]); MFSF(P8(B1a),lacc1); o1[1]=MF8P(P8(B1a),vf1,o1[1]);
  #undef SL4A
  #undef SL4B
  #undef STEPX
  #undef MF8
  #undef MF8P
  #undef MFSF
  #undef PIN
  #undef E2
  #undef K2
  #undef SL8
  #undef P8
  #undef KR8
  #undef DMA1
  asm volatile("s_waitcnt lgkmcnt(0)\n\ts_barrier":::"memory");
  { int le=lane; asm volatile("":"+v"(le)); const int r32e=le&31,hie=le>>5;
    float*wse=(float*)(shm+A64_WS)+wid*64;
    if(le<16){wse[le]=lacc0[0];wse[16+le]=lacc0[1];wse[32+le]=lacc1[0];wse[48+le]=lacc1[1];} asm volatile("s_waitcnt lgkmcnt(0)":::"memory");
    bf16*Ow=O+(rowbase+q0+wid*64)*OP+h*D;
    bf16*stg=(bf16*)(shm)+wid*4096;
    #pragma unroll
    for(int r=0;r<16;++r){const int orow=crow(r,hie); const float rl=__builtin_amdgcn_rcpf(wse[orow]);
      #pragma unroll
      for(int d0=0;d0<2;++d0)stg[orow*64+d0*32+r32e]=__float2bfloat16(o0[d0][r]*rl);}
    #pragma unroll
    for(int r=0;r<16;++r){const int orow=crow(r,hie); const float rl=__builtin_amdgcn_rcpf(wse[32+orow]);
      #pragma unroll
      for(int d0=0;d0<2;++d0)stg[(32+orow)*64+d0*32+r32e]=__float2bfloat16(o1[d0][r]*rl);}
    asm volatile("s_waitcnt lgkmcnt(0)":::"memory");
    #pragma unroll
    for(int i=0;i<8;++i){const int row=i*8+(le>>3),ch2=le&7; const u32x4 v=*(const u32x4*)(stg+row*64+ch2*8); ATTN_STORE16(Ow+(long)row*OP+ch2*8,v);} }
  asm volatile("s_waitcnt lgkmcnt(0)\n\ts_barrier":::"memory");
}
constexpr int ATTN_LDS_BYTES=LDS_BYTES;
struct AttnTensors { const bf16* Q; const bf16* K; const bf16* V; bf16* O; const unsigned char* Q8; const unsigned char* K8; const unsigned char* V8T; };
struct AttnUnit { int b; int h; int qb; };
struct StaticOrder {
  int vcu, G;
  __device__ __forceinline__ StaticOrder(int v,int g):vcu(v),G(g){}
  __device__ __forceinline__ bool next(int i,AttnUnit&u)const{
    int id; if(G==256){ if(i>=4)return false; id=(vcu>>5)*128+(vcu&31)*4+i; } else { id=i*G+vcu; if(id>=1024)return false; }
    const int x=id>>7, un=id&127; u.b=x>>1; u.h=(x&1)*4+(un>>5); u.qb=un&31; return true; }
  __device__ __forceinline__ bool next64(int i,AttnUnit&u)const{
    int id; if(G==256){ if(i>=2)return false; id=(vcu>>5)*64+(vcu&31)*2+i; } else { id=i*G+vcu; if(id>=512)return false; }
    const int x=id>>6, un=id&63; u.b=x>>1; u.h=(x&1)*4+(un>>4); u.qb=un&15; return true; }
};
template<class Sched,int THRL=8> __device__ __forceinline__ void attn_phase(char*lds,const AttnTensors&T,const Sched&S,bool noref,bool pv8){
  AttnUnit u;
  if(noref&&pv8){ for(int i=0;S.next64(i,u);++i){ attn_unit64ff(u.b,u.h,u.qb,T.Q8,T.K8,T.V8T,T.O,lds); } }
  else if(noref){ for(int i=0;S.next64(i,u);++i){ attn_unit64f8(u.b,u.h,u.qb,T.Q8,T.K8,T.V,T.O,lds); } }
  else     { for(int i=0;S.next(i,u);++i){ attn_unit<THRL,false>(u.b,u.h,u.qb,T.Q,T.K,T.V,T.O,lds); } }
}
#undef SBAR
#undef WAIT_BAR
}

constexpr int NWAVES = 8;
constexpr int NPHASE = 8;
constexpr size_t CTL_ZERO_BYTES = 64 * 1024;
constexpr int CW_BAR = 1024;
constexpr int RING_OFF = 0, RING_BYTES = 131072;
constexpr int LDSCTL_OFF = RING_BYTES, MISC_OFF = LDSCTL_OFF + 320;
constexpr int LDS_BYTES = 147456;

#define GAS __attribute__((address_space(1)))
#define LAS __attribute__((address_space(3)))
typedef unsigned v4u __attribute__((ext_vector_type(4)));
typedef unsigned v2u __attribute__((ext_vector_type(2)));
typedef float f32x4 __attribute__((ext_vector_type(4)));
typedef short bf16x8 __attribute__((ext_vector_type(8)));
#define LDS_WAIT() asm volatile("s_waitcnt lgkmcnt(0)" ::: "memory")
#define VM_WAIT() asm volatile("s_waitcnt vmcnt(0)" ::: "memory")
__device__ __forceinline__ unsigned pk2(float lo, float hi) { return (unsigned)f2bf(lo) | ((unsigned)f2bf(hi) << 16); }
__device__ __forceinline__ unsigned pk4_f8(float a, float b, float c, float d) { int w = __builtin_amdgcn_cvt_pk_fp8_f32(a, b, 0, false); w = __builtin_amdgcn_cvt_pk_fp8_f32(c, d, w, true); return (unsigned)w; }

#define XB_TMO      128
#define XB_XCNT(j)  (256  + 64 * (j))
#define XB_XSUB(j)  (1280 + 64 * (j))
#define XB_XGEN(j)  (2304 + 64 * (j))
#define XB_TOP      3328
#define XB_TOPGEN   3392
#define XCD_BAR_WORDS 3456
#define XB_SPIN_CAP (1u << 18)
__device__ __forceinline__ unsigned xb_ld(unsigned* p)              { return __hip_atomic_load(p, __ATOMIC_RELAXED, __HIP_MEMORY_SCOPE_AGENT); }
__device__ __forceinline__ unsigned xb_add(unsigned* p, unsigned v) { return __hip_atomic_fetch_add(p, v, __ATOMIC_RELAXED, __HIP_MEMORY_SCOPE_AGENT); }
__device__ __forceinline__ unsigned xb_xcc_id() { return (unsigned)__builtin_amdgcn_s_getreg((3 << 11) | 20) & 0xFu; }
#define XB_SPIN(cond, bar) do { unsigned _sp = 0; while (cond) { __builtin_amdgcn_s_sleep(1); \
    if ((++_sp & 255u) == 0u) { if (xb_ld(&(bar)[XB_TMO])) break; if (_sp > XB_SPIN_CAP) { atomicAdd(&(bar)[XB_TMO], 1u); break; } } } } while (0)
struct XcdBarrier { unsigned* bar; unsigned x; volatile LAS unsigned* st; };
__device__ __forceinline__ XcdBarrier xcd_barrier_post(unsigned* bar, volatile LAS unsigned* st) {
    XcdBarrier b; b.bar = bar; b.x = xb_xcc_id(); b.st = st;
    if (threadIdx.x == 0) (void)xb_add(&bar[XB_XCNT(b.x)], 1u);
    return b;
}
__device__ __forceinline__ void xcd_barrier_complete(unsigned* bar, unsigned x, unsigned& nloc, unsigned& nx) {
    const unsigned G = gridDim.x * gridDim.y * gridDim.z;
    unsigned sum, cnt, mine, sp = 0u;
    for (;;) {
        sum = 0u; cnt = 0u; mine = 0u;
#pragma unroll
        for (unsigned j = 0; j < 16; ++j) { const unsigned c = xb_ld(&bar[XB_XCNT(j)]); sum += c; cnt += (c > 0u) ? 1u : 0u; mine = (j == x) ? c : mine; }
        if (sum == G) break;
        __builtin_amdgcn_s_sleep(1);
        if ((++sp & 255u) == 0u) { if (xb_ld(&bar[XB_TMO])) break; if (sp > XB_SPIN_CAP) { atomicAdd(&bar[XB_TMO], 1u); break; } }
    }
    nloc = mine > 0u ? mine : 1u; nx = cnt > 0u ? cnt : 1u;
}
__device__ __forceinline__ void xcd_barrier(const XcdBarrier& b) {
    asm volatile("s_waitcnt vmcnt(0)" ::: "memory");
    __syncthreads();
    if (threadIdx.x == 0) {
        unsigned* bar = b.bar;
        __builtin_amdgcn_s_waitcnt(0);
        unsigned nloc = b.st[0], nx = b.st[1];
        if (nloc == 0u) { xcd_barrier_complete(bar, b.x, nloc, nx); b.st[0] = nloc; b.st[1] = nx; }
        const unsigned old = xb_add(&bar[XB_XSUB(b.x)], 1u);
        const unsigned gen = old / nloc;
        if (old + 1u == (gen + 1u) * nloc) {
            __builtin_amdgcn_fence(__ATOMIC_RELEASE, "agent");
            asm volatile("s_waitcnt vmcnt(0)" ::: "memory");
            const unsigned og = xb_add(&bar[XB_TOP], 1u);
            const unsigned tg = og / nx;
            if (og + 1u == (tg + 1u) * nx) xb_add(&bar[XB_TOPGEN], 1u);
            else XB_SPIN(xb_ld(&bar[XB_TOPGEN]) == tg, bar);
            __builtin_amdgcn_fence(__ATOMIC_ACQUIRE, "agent");
            asm volatile("s_waitcnt vmcnt(0)" ::: "memory");
        } else {
            XB_SPIN(xb_ld(&bar[XB_TOPGEN]) == gen, bar);
            __builtin_amdgcn_fence(__ATOMIC_ACQUIRE, "agent");
            asm volatile("s_waitcnt vmcnt(0)" ::: "memory");
        }
    }
    __syncthreads();
}

template <int NV, bool SILU>
__device__ __forceinline__ void gemv32(const float* v0, const float* v1, const float* v2, const float* v3, const float* v4, const float* W, int ldw, int col0, const float* bias, float* out, int ostride,
                                       LAS float* scr, int wave, int lane) {
    const float* vp[5] = {v0, v1, v2, v3, v4};
    const int cq = lane & 7, rs = lane >> 3;
    float acc[NV][4];
#pragma unroll
    for (int v = 0; v < NV; ++v)
#pragma unroll
        for (int e = 0; e < 4; ++e) acc[v][e] = 0.f;
#pragma unroll 4
    for (int i = 0; i < 16; ++i) { const int k = wave * 128 + i * 8 + rs; const f32x4 w = *(const f32x4*)(W + (size_t)k * ldw + col0 + 4 * cq);
#pragma unroll
        for (int v = 0; v < NV; ++v) { float a = vp[v][k]; if (SILU) a = siluf_(a);
#pragma unroll
            for (int e = 0; e < 4; ++e) acc[v][e] = fmaf(a, w[e], acc[v][e]); } }
#pragma unroll
    for (int v = 0; v < NV; ++v)
#pragma unroll
        for (int e = 0; e < 4; ++e) { float s = acc[v][e]; s += __shfl_xor(s, 8); s += __shfl_xor(s, 16); s += __shfl_xor(s, 32); acc[v][e] = s; }
    if (lane < 8) {
#pragma unroll
        for (int v = 0; v < NV; ++v)
#pragma unroll
            for (int e = 0; e < 4; ++e) scr[(wave * NV + v) * 32 + 4 * cq + e] = acc[v][e]; }
    __syncthreads();
    const int tid = wave * 64 + lane;
    if (tid < NV * 32) { const int v = tid >> 5, j = tid & 31; float s = 0.f;
#pragma unroll
        for (int w = 0; w < 8; ++w) s += scr[(w * NV + v) * 32 + j];
        if (bias) s += bias[col0 + j];
        out[(size_t)v * ostride + col0 + j] = s; }
    __syncthreads();
}
__device__ __forceinline__ void transpose_item(const float* W, int N, int k0, int n0, bf16_t* WT, int ldt, int drow0, int dk0, LAS float* scr, int lane, unsigned char* WT8 = nullptr) {
#pragma unroll 8
    for (int i = 0; i < 32; ++i) { const int kk = 2 * i + (lane >> 5); scr[kk * 33 + (lane & 31)] = W[(size_t)(k0 + kk) * N + n0 + (lane & 31)]; }
    LDS_WAIT(); asm volatile("" ::: "memory");
    const int c = lane & 7;
#pragma unroll
    for (int j = 0; j < 4; ++j) { const int n = (lane >> 3) + 8 * j; const LAS float* s = scr + (8 * c) * 33 + n;
        v4u o; o.x = pk2(s[0 * 33], s[1 * 33]); o.y = pk2(s[2 * 33], s[3 * 33]); o.z = pk2(s[4 * 33], s[5 * 33]); o.w = pk2(s[6 * 33], s[7 * 33]);
        *(GAS v4u*)(WT + (size_t)(drow0 + n) * ldt + dk0 + 8 * c) = o;
        if (WT8) { v2u o8; o8.x = pk4_f8(s[0 * 33], s[1 * 33], s[2 * 33], s[3 * 33]); o8.y = pk4_f8(s[4 * 33], s[5 * 33], s[6 * 33], s[7 * 33]); *(GAS v2u*)(WT8 + (size_t)(drow0 + n) * ldt + dk0 + 8 * c) = o8; } }
    LDS_WAIT(); asm volatile("" ::: "memory");
}
__device__ __forceinline__ void transpose_item_w1(const float* W, int k0, int n0, bf16_t* W1s, const float* n2g, const float* mod, LAS float* scr, int lane) {
#pragma unroll 8
    for (int i = 0; i < 32; ++i) { const int kk = 2 * i + (lane >> 5); scr[kk * 33 + (lane & 31)] = W[(size_t)(k0 + kk) * D_FF + n0 + (lane & 31)]; }
    LDS_WAIT(); asm volatile("" ::: "memory");
    const int c = lane & 7, kb = k0 + 8 * c;
    const f32x4 ga = *(const f32x4*)(n2g + kb), gb = *(const f32x4*)(n2g + kb + 4);
    float gs[BATCH][8];
#pragma unroll
    for (int b = 0; b < BATCH; ++b) { const float* sc = mod + (size_t)b * NMOD + 4 * DM + kb; const f32x4 sa = *(const f32x4*)sc, sb = *(const f32x4*)(sc + 4);
        gs[b][0] = ga.x * (1.f + sa.x); gs[b][1] = ga.y * (1.f + sa.y); gs[b][2] = ga.z * (1.f + sa.z); gs[b][3] = ga.w * (1.f + sa.w);
        gs[b][4] = gb.x * (1.f + sb.x); gs[b][5] = gb.y * (1.f + sb.y); gs[b][6] = gb.z * (1.f + sb.z); gs[b][7] = gb.w * (1.f + sb.w); }
#pragma unroll
    for (int j = 0; j < 4; ++j) { const int n = (lane >> 3) + 8 * j; const LAS float* s = scr + (8 * c) * 33 + n;
        const float w0 = s[0 * 33], w1 = s[1 * 33], w2 = s[2 * 33], w3 = s[3 * 33], w4 = s[4 * 33], w5 = s[5 * 33], w6 = s[6 * 33], w7 = s[7 * 33];
#pragma unroll
        for (int b = 0; b < BATCH; ++b) { v4u o; o.x = pk2(w0 * gs[b][0], w1 * gs[b][1]); o.y = pk2(w2 * gs[b][2], w3 * gs[b][3]); o.z = pk2(w4 * gs[b][4], w5 * gs[b][5]); o.w = pk2(w6 * gs[b][6], w7 * gs[b][7]);
            *(GAS v4u*)(W1s + (size_t)b * D_FF * DM + (size_t)(n0 + n) * DM + kb) = o; } }
    LDS_WAIT(); asm volatile("" ::: "memory");
}
__device__ __forceinline__ void norm_mod_row(const float* xrow, const float* g, const float* shift, const float* scale, bf16_t* orow, unsigned char* orow8, int lane) {
    const GAS f32x4* xr = (const GAS f32x4*)xrow + lane;
    f32x4 v[4]; float s = 0.f;
#pragma unroll
    for (int j = 0; j < 4; ++j) { v[j] = xr[64 * j]; s += (v[j].x * v[j].x + v[j].y * v[j].y) + (v[j].z * v[j].z + v[j].w * v[j].w); }
    const float rstd = rsqrtf(wave_sum(s) * (1.f / DM) + EPS);
    GAS v2u* o8 = (GAS v2u*)orow + lane;
    GAS unsigned* o4 = (GAS unsigned*)orow8 + lane;
#pragma unroll
    for (int j = 0; j < 4; ++j) { const f32x4 gg = *((const f32x4*)g + lane + 64 * j), sc = *((const f32x4*)scale + lane + 64 * j), sh = *((const f32x4*)shift + lane + 64 * j);
        const f32x4 y = v[j] * rstd * gg * (sc + 1.0f) + sh; v2u w; w.x = pk2(y.x, y.y); w.y = pk2(y.z, y.w); o8[64 * j] = w; o4[64 * j] = pk4_f8(y.x, y.y, y.z, y.w); }
}

__device__ __forceinline__ void gmlp_unit(int chunk, int g, const bf16_t* U, const bf16_t* VGn, const bf16_t* Wsb, const float* bs, bf16_t* AG, LAS unsigned char* scr, int lane) {
    const bf16_t* src = VGn + (size_t)(chunk * 128) * 512 + g * 64;
    {
        v4u tv[16];
#pragma unroll
        for (int it = 0; it < 16; ++it) { const int piece = it * 64 + lane, q = piece >> 3, c0 = (piece & 7) * 8; tv[it] = *(const v4u*)(src + (size_t)q * 512 + c0); }
        const int c0 = (lane & 7) * 8, L8 = (lane & 1) << 3;
        LAS unsigned char* bp = scr + c0 * 256 + (lane >> 3) * 2 + (L8 << 4);
        LAS unsigned char* bm = scr + c0 * 256 + (lane >> 3) * 2 - (L8 << 4);
#pragma unroll
        for (int it = 0; it < 16; ++it) { const v4u v = tv[it];
#pragma unroll
            for (int e = 0; e < 8; ++e) { const int A = it ^ e; const unsigned short val = (unsigned short)((e & 1) ? (v[e >> 1] >> 16) : (v[e >> 1] & 0xffffu));
                *(LAS unsigned short*)(((A & 8) ? bm : bp) + e * 256 + (A << 4)) = val; } }
    }
    LDS_WAIT(); asm volatile("" ::: "memory");
    const int fr = lane & 15, fq = lane >> 4;
#pragma unroll 1
    for (int ph = 0; ph < 2; ++ph) {
        bf16x8 Yf[2][4]; v2u uu[4][4]; float bias[4];
#pragma unroll
        for (int pt = 0; pt < 4; ++pt) Yf[0][pt] = *(const bf16x8*)(Wsb + ((size_t)g * 128 + 64 * ph + 16 * pt + fr) * 128 + 8 * fq);
#pragma unroll
        for (int pt = 0; pt < 4; ++pt) { const int p = 64 * ph + 16 * pt + fr; const size_t row = (size_t)chunk * 128 + p; bias[pt] = bs[g * 128 + p];
#pragma unroll
            for (int ct = 0; ct < 4; ++ct) uu[pt][ct] = *(const v2u*)(U + row * 512 + g * 64 + 16 * ct + 4 * fq); }
        f32x4 acc[4][4];
#pragma unroll
        for (int ct = 0; ct < 4; ++ct)
#pragma unroll
            for (int pt = 0; pt < 4; ++pt) acc[ct][pt] = (f32x4){0.f, 0.f, 0.f, 0.f};
#pragma unroll
        for (int ks = 0; ks < 4; ++ks) {
            bf16x8 X[4];
            if (ks < 3) {
#pragma unroll
                for (int pt = 0; pt < 4; ++pt) Yf[(ks + 1) & 1][pt] = *(const bf16x8*)(Wsb + ((size_t)g * 128 + 64 * ph + 16 * pt + fr) * 128 + 32 * (ks + 1) + 8 * fq); }
#pragma unroll
            for (int ct = 0; ct < 4; ++ct) { const int c = 16 * ct + fr; X[ct] = *(const LAS bf16x8*)(scr + c * 256 + (((4 * ks + fq) ^ (c & 15)) << 4)); }
#pragma unroll
            for (int ct = 0; ct < 4; ++ct)
#pragma unroll
                for (int pt = 0; pt < 4; ++pt) acc[ct][pt] = __builtin_amdgcn_mfma_f32_16x16x32_bf16(X[ct], Yf[ks & 1][pt], acc[ct][pt], 0, 0, 0);
        }
#pragma unroll
        for (int pt = 0; pt < 4; ++pt) { const int p = 64 * ph + 16 * pt + fr; const size_t row = (size_t)chunk * 128 + p;
#pragma unroll
            for (int ct = 0; ct < 4; ++ct) { const int c = 16 * ct + 4 * fq; const f32x4 a = acc[ct][pt]; const v2u u2 = uu[pt][ct];
                v2u w; w.x = pk2((a[0] + bias[pt]) * __uint_as_float(u2.x << 16), (a[1] + bias[pt]) * __uint_as_float(u2.x & 0xffff0000u));
                w.y = pk2((a[2] + bias[pt]) * __uint_as_float(u2.y << 16), (a[3] + bias[pt]) * __uint_as_float(u2.y & 0xffff0000u));
                *(v2u*)(AG + row * 1024 + 512 + g * 64 + c) = w; } }
    }
    LDS_WAIT(); asm volatile("" ::: "memory");
}

struct Args { const float* in[19]; float* out; unsigned char* ws; int ph_lo, ph_hi; };
__global__ void __launch_bounds__(NWAVES * 64, 2) mega_fwd(Args args) {
    extern __shared__ __attribute__((aligned(16))) unsigned char lds[];
    LAS unsigned char* L = (LAS unsigned char*)lds;
    volatile LAS unsigned* MISC = (volatile LAS unsigned*)(L + MISC_OFF);
    const int tid = threadIdx.x, lane = tid & 63, wave = __builtin_amdgcn_readfirstlane(tid >> 6);
    const int G = gridDim.x, bx = blockIdx.x, vcu = (G % 8 == 0) ? (bx % 8) * (G / 8) + bx / 8 : bx;
    unsigned char* ws = args.ws;
    const float* x = args.in[0]; const float* c = args.in[1]; const float* ctx = args.in[2]; const float* c_ctx = args.in[3];
    const float* w_mod = args.in[4]; const float* b_mod = args.in[5]; const float* norm1_g = args.in[6]; const float* norm2_g = args.in[7];
    const float* w_in = args.in[8]; const float* q_norm_g = args.in[9]; const float* k_norm_g = args.in[10]; const float* gm_norm_g = args.in[11];
    const float* gm_ws = args.in[12]; const float* gm_bs = args.in[13]; const float* w_br_attn = args.in[14]; const float* w_br_gm = args.in[15];
    const float* w_out = args.in[16]; const float* w_ff1 = args.in[17]; const float* w_ff2 = args.in[18];
    float* out = args.out;
    float* mod = (float*)(ws + WS_MOD); float* cvec = (float*)(ws + WS_CVEC); float* rope = (float*)(ws + WS_ROPE); float* ssq = (float*)(ws + WS_SSQ);
    bf16_t* Win_t = (bf16_t*)(ws + WS_WIN); bf16_t* Wm_t = (bf16_t*)(ws + WS_WM); bf16_t* Wout_t = (bf16_t*)(ws + WS_WOUT); bf16_t* W1_t = (bf16_t*)(ws + WS_W1); bf16_t* W2_t = (bf16_t*)(ws + WS_W2); bf16_t* Wsb = (bf16_t*)(ws + WS_WS);
    bf16_t* XN = (bf16_t*)(ws + WS_XN); bf16_t* Y = (bf16_t*)(ws + WS_Y); bf16_t* Kb = (bf16_t*)(ws + WS_K); bf16_t* Vb = (bf16_t*)(ws + WS_V);
    bf16_t* GAb = (bf16_t*)(ws + WS_GA); bf16_t* GBb = (bf16_t*)(ws + WS_GB); bf16_t* Qb = (bf16_t*)(ws + WS_Q); bf16_t* Ub = (bf16_t*)(ws + WS_U); bf16_t* VGb = (bf16_t*)(ws + WS_VG);
    bf16_t* AG = (bf16_t*)(ws + WS_AG); bf16_t* XN2 = (bf16_t*)(ws + WS_XN2); bf16_t* HM = (bf16_t*)(ws + WS_HM); bf16_t* W1s = (bf16_t*)(ws + WS_W1S);

    for (int u = tid; u < (LDS_BYTES - LDSCTL_OFF) / 4; u += NWAVES * 64) ((LAS unsigned*)(L + LDSCTL_OFF))[u] = 0u;
    __syncthreads();
    const int lo = args.ph_lo, hi = args.ph_hi;
    XcdBarrier bar; bar.bar = (unsigned*)(ws + WS_CTL) + CW_BAR; bar.x = 0; bar.st = nullptr;
    if (hi - lo > 1) bar = xcd_barrier_post((unsigned*)(ws + WS_CTL) + CW_BAR, MISC + 8);
#define IN(k) (lo <= (k) && (k) < hi)
#define SEAM(k) do { if (IN(k) && IN((k) + 1)) xcd_barrier(bar); } while (0)

    if (IN(0)) {
        LAS float* scr = (LAS float*)(L + RING_OFF);
        if (vcu < NMOD / 32) gemv32<5, true>(c, c + DM, c + 2 * DM, c + 3 * DM, c_ctx, w_mod, NMOD, 32 * vcu, b_mod, mod, NMOD, scr, wave, lane);
    }
    SEAM(0);
    constexpr int I_IN = 16 * 120, I_BA = 8 * 32, I_BG = 8 * 32, I_O = 16 * 32, I_1 = 16 * 128, I_2 = 64 * 32, I_WS = 256, I_RP = 32;
    if (IN(1)) {
        {
            const int gw = vcu * NWAVES + wave, NGW = G * NWAVES;
            for (int m = gw; m < MTOK + MCTX; m += NGW) { const float* xr = m < MTOK ? x + (size_t)m * DM : ctx + (size_t)(m - MTOK) * DM; const float* mv = mod + (size_t)(m < MTOK ? m / SEQ : 4) * NMOD;
                norm_mod_row(xr, norm1_g, mv, mv + DM, XN + (size_t)m * DM, ws + WS_XN8 + (size_t)m * DM, lane); }
        }
        {
            LAS float* wscr = (LAS float*)(L + RING_OFF + wave * 16384);
            unsigned* iq = (unsigned*)(ws + WS_CTL) + 128;
            for (;;) {
                __syncthreads();
                if (tid == 0) MISC[17] = __hip_atomic_fetch_add(iq, (unsigned)NWAVES, __ATOMIC_RELAXED, __HIP_MEMORY_SCOPE_AGENT);
                __syncthreads();
                const int it0 = (int)MISC[17];
                if (it0 >= I_IN + I_WS + I_RP) break;
                int r = it0 + wave;
                if (r >= I_IN + I_WS + I_RP) continue;
                if (r < I_IN) { const int kb = r / 120, nb = r % 120, n0 = 32 * nb, within = n0 & 255; const int gcol = n0 >= COL_GB ? n0 - COL_GB : n0 - COL_GA;
                    const int drow0 = n0 >= COL_GA ? 256 * (7 + (gcol >> 7)) + (n0 >= COL_GB ? 128 : 0) + (gcol & 127) : (n0 & ~255) + 128 * ((within & 63) >> 5) + 32 * (within >> 6);
                    transpose_item(w_in, D_IN, 64 * kb, n0, Win_t, DM, drow0, 64 * kb, wscr, lane, ws + WS_WIN8); continue; } r -= I_IN;
                if (r < I_WS) { const int e0 = r * 512 + lane * 8; const f32x4 a = *(const f32x4*)(gm_ws + e0), b = *(const f32x4*)(gm_ws + e0 + 4);
                    v4u o; o.x = pk2(a.x, a.y); o.y = pk2(a.z, a.w); o.z = pk2(b.x, b.y); o.w = pk2(b.z, b.w); *(v4u*)(Wsb + e0) = o; continue; } r -= I_WS;
                { const int i = r * 64 + lane, pos = i >> 4, j = i & 15; const float inv = powf(10000.0f, -(float)(2 * j) / 32.0f); const float ang = (float)pos * inv;
                  rope[pos * 32 + j] = cosf(ang); rope[pos * 32 + 16 + j] = sinf(ang); }
            }
        }
    }
    SEAM(1);
    float mq = 0.f, mk = 0.f;
    for (int d = 0; d < HD; ++d) { mq = fmaxf(mq, fabsf(q_norm_g[d])); mk = fmaxf(mk, fabsf(k_norm_g[d])); }
    const bool noref = (64.0f * QSCALE_LOG2E * mq * mk) <= 50.0f;
    const bool pv8 = (64.0f * QSCALE_LOG2E * mq * mk) <= 14.0f;
    if (IN(2)) {
        pg8::EpiInProj E{Kb, Vb, Qb, Ub, VGb, GAb, GBb, q_norm_g, k_norm_g, gm_norm_g, rope, ws + WS_K8, ws + WS_Q8, ws + WS_V8T, (noref && pv8) ? 1 : 0};
        {
            pg8::Gemm g8{(const bf16_t*)(ws + WS_XN8), (const bf16_t*)(ws + WS_WIN8), DM / 2, DM / 2, DM / 2}; pg8::OrderInProjF8 S8; S8.init(G, bx);
            pg8::gemm_phase<pg8::EpiInProj, pg8::OrderInProjF8, true, true>(L + RING_OFF, g8, S8, E); }
        pg8::Gemm g{XN, Win_t, DM, DM, DM}; pg8::OrderInProjBf S; S.init(G, bx);
        pg8::gemm_phase<pg8::EpiInProj, pg8::OrderInProjBf, true>(L + RING_OFF, g, S, E);
        {
            const int rem = (128 * 15 + 4) % G; const bool spare = rem == 0 || bx >= rem; const int n_sp = rem == 0 ? G : G - rem, idx = rem == 0 ? bx : bx - rem;
            if (spare) {
                LAS float* scr = (LAS float*)(L + RING_OFF);
                for (int cgp = idx; cgp < D_FF / 32; cgp += n_sp) gemv32<4, false>(mod + 3 * DM, mod + NMOD + 3 * DM, mod + 2 * NMOD + 3 * DM, mod + 3 * NMOD + 3 * DM, nullptr, w_ff1, D_FF, 32 * cgp, nullptr, cvec, D_FF, scr, wave, lane);
                LAS float* wscr = (LAS float*)(L + RING_OFF + wave * 16384);
                for (int it = idx * NWAVES + wave; it < I_BA + I_BG + I_O + I_1 + I_2; it += n_sp * NWAVES) {
                    int r = it;
                    if (r < I_BA) { transpose_item(w_br_attn, DM, 64 * (r / 32), 32 * (r % 32), Wm_t, DM, 32 * (r % 32), 64 * (r / 32), wscr, lane); continue; } r -= I_BA;
                    if (r < I_BG) { transpose_item(w_br_gm, DM, 64 * (r / 32), 32 * (r % 32), Wm_t, DM, 32 * (r % 32), 512 + 64 * (r / 32), wscr, lane); continue; } r -= I_BG;
                    if (r < I_O) { transpose_item(w_out, DM, 64 * (r / 32), 32 * (r % 32), Wout_t, DM, 32 * (r % 32), 64 * (r / 32), wscr, lane); continue; } r -= I_O;
                    if (r < I_1) { transpose_item_w1(w_ff1, 64 * (r / 128), 32 * (r % 128), W1s, norm2_g, mod, wscr, lane); continue; } r -= I_1;
                    transpose_item(w_ff2, DM, 64 * (r / 32), 32 * (r % 32), W2_t, D_FF, 32 * (r % 32), 64 * (r / 32), wscr, lane);
                }
            }
        }
    }
    SEAM(2);
    if (IN(3)) {
        const attn_body::AttnTensors AT{(const attn_body::bf16*)Qb, (const attn_body::bf16*)Kb, (const attn_body::bf16*)Vb, (attn_body::bf16*)AG, ws + WS_Q8, ws + WS_K8, ws + WS_V8T};
        const attn_body::StaticOrder S(vcu, G);
        attn_body::attn_phase<attn_body::StaticOrder>((char*)lds + RING_OFF, AT, S, noref, pv8);
        {
            unsigned* gq = (unsigned*)(ws + WS_CTL) + 64;
            for (;;) {
                __syncthreads();
                if (tid == 0) MISC[16] = __hip_atomic_fetch_add(gq, 1u, __ATOMIC_RELAXED, __HIP_MEMORY_SCOPE_AGENT);
                __syncthreads();
                const int ch = (int)MISC[16];
                if (ch >= MTOK / 128) break;
                gmlp_unit(ch, wave, Ub, VGb, Wsb, gm_bs, AG, L + RING_OFF + wave * 16384, lane);
            }
        }
#ifdef ABL_PROBE
        { attn_body::AttnUnit pu; if (S.next(0, pu)) attn_body::attn_unit<8, true, ABL_PROBE>(pu.b, pu.h, pu.qb, AT.Q, AT.K, AT.V, (attn_body::bf16*)XN2, (char*)lds + RING_OFF); }
#endif
    }
    SEAM(3);
    if (IN(4)) {
        pg8::Gemm g{AG, Wm_t, DM, DM, 512}; pg8::OrderMerge S; S.init(MTOK / 256, DM / 256, G, bx);
        pg8::EpiMerge E{GAb, GBb, Y};
        pg8::gemm_phase<pg8::EpiMerge, pg8::OrderMerge, true>(L + RING_OFF, g, S, E);
    }
    SEAM(4);
    if (IN(5)) {
        pg8::Gemm g{Y, Wout_t, DM, DM, DM}; pg8::OrderPlain S; S.init(MTOK / 256, DM / 256, G, bx);
        pg8::EpiOutProj E{x, XN2, ssq, mod};
        pg8::gemm_phase<pg8::EpiOutProj, pg8::OrderPlain, true>(L + RING_OFF, g, S, E);
    }
    SEAM(5);
    if (IN(6)) {
        pg8::Gemm g{XN2, W1s, DM, DM, DM}; pg8::OrderBatchB S; S.init(MTOK / 256, D_FF / 256, G, bx, (long)D_FF * DM * 2);
        pg8::EpiFfnUp E{HM, ssq, cvec};
        pg8::gemm_phase<pg8::EpiFfnUp, pg8::OrderBatchB, true>(L + RING_OFF, g, S, E);
    }
    SEAM(6);
    if (IN(7)) {
        pg8::Gemm g{HM, W2_t, 256, D_FF, D_FF}; pg8::OrderPlain S; S.init(MTOK / 256, DM / 256, G, bx, 1);
        pg8::EpiFfnDown E{out, XN2, mod};
        pg8::gemm_phase<pg8::EpiFfnDown, pg8::OrderPlain, true, false, true>(L + RING_OFF, g, S, E);
    }
#undef IN
#undef SEAM
}

extern "C" void kernel_launch(void* const* d_in, const int* in_sizes, int n_in, void* d_out, int out_size, void* d_ws, size_t ws_size, hipStream_t stream) {
    if (n_in != 19 || in_sizes[0] != MTOK * DM || out_size != MTOK * DM || ws_size < WS_END) { fprintf(stderr, "kernel_launch: unexpected shapes (n_in %d, in0 %d, out %d, ws %zu)\n", n_in, n_in > 0 ? in_sizes[0] : -1, out_size, ws_size); return; }
    static int grid = 0;
    if (grid == 0) {
        int dev = 0, cus = 0, per_cu = 0;
        if (hipGetDevice(&dev) != hipSuccess || hipDeviceGetAttribute(&cus, hipDeviceAttributeMultiprocessorCount, dev) != hipSuccess) { fprintf(stderr, "kernel_launch: device query failed\n"); grid = -1; return; }
        if (hipFuncSetAttribute((const void*)mega_fwd, hipFuncAttributeMaxDynamicSharedMemorySize, LDS_BYTES) != hipSuccess) { fprintf(stderr, "kernel_launch: hipFuncSetAttribute failed\n"); grid = -1; return; }
        if (hipOccupancyMaxActiveBlocksPerMultiprocessor(&per_cu, (const void*)mega_fwd, NWAVES * 64, LDS_BYTES) != hipSuccess || per_cu < 1) fprintf(stderr, "kernel_launch: occupancy query reports %d blocks per CU\n", per_cu);
        (void)hipGetLastError();
        grid = cus;
    }
    if (grid < 0) return;
    Args a{};
    for (int i = 0; i < 19; ++i) a.in[i] = (const float*)d_in[i];
    a.out = (float*)d_out; a.ws = (unsigned char*)d_ws;
    (void)hipMemsetAsync((char*)d_ws + WS_CTL, 0, CTL_ZERO_BYTES, stream);
    a.ph_lo = 0; a.ph_hi = NPHASE;
    hipLaunchKernelGGL(mega_fwd, dim3(grid), dim3(NWAVES * 64), LDS_BYTES, stream, a);
}
```
